# Optimizing an MI355X kernel written in HIP

```python
import jax, jax.numpy as jnp
from jax import lax
import numpy as np

D_MODEL = 1024
BATCH = 32
SEQ = 256
DEPTH = 1
DEC_BATCH = 8
DEC_SEQ = 4096
PAST_LEN = 256

GRID_W = 64
MIX_WIDTH = D_MODEL
A_WIDTH = MIX_WIDTH // 2
B_WIDTH = MIX_WIDTH - A_WIDTH
HEAD_DIM = 64
A_HEADS = A_WIDTH // HEAD_DIM
DECAY_LORA = 64
ICLR_LORA = 64
IN_WIDTH = 4 * A_WIDTH + 4 * B_WIDTH
IN_SPLITS = tuple(int(s) for s in np.cumsum([A_WIDTH] * 4 + [B_WIDTH] * 3))
NORM_EPS = 1e-6
GN_EPS = 64e-5

kernel_name = "bidir_rwkv7_shortconv_hybrid_dit_step"


def _rmsnorm(x, g):
    xf = x.astype(jnp.float32)
    y = xf * lax.rsqrt(jnp.mean(xf * xf, axis=-1, keepdims=True) + NORM_EPS)
    return (y * g.astype(jnp.float32)).astype(x.dtype)


def _centred_taps(p, axis):
    n = p.shape[axis]
    pad = [(0, 0)] * p.ndim
    pad[axis] = (1, 1)
    pp = jnp.pad(p, pad)
    return (lax.slice_in_dim(pp, 0, n, axis=axis), lax.slice_in_dim(pp, 2, n + 2, axis=axis))


def _token_shift(p, mu, is_latent):
    b, t, ch = p.shape
    if is_latent:
        q = p.reshape(b, t // GRID_W, GRID_W, ch)
        axis = 2
    else:
        q = p
        axis = 1
    prev, nxt = _centred_taps(q, axis)
    return (q + mu * (0.5 * (prev + nxt) - q)).reshape(b, t, ch)


def _short_conv(u, w, is_latent):
    if not is_latent:
        prev, nxt = _centred_taps(u, 1)
        return w[0] * prev + w[1] * u + w[2] * nxt
    b, t, ch = u.shape
    half = ch // 2
    g = u.reshape(b, t // GRID_W, GRID_W, ch)
    ph, nh = _centred_taps(g[..., :half], 2)
    pv, nv = _centred_taps(g[..., half:], 1)
    prev = jnp.concatenate([ph, pv], axis=-1)
    nxt = jnp.concatenate([nh, nv], axis=-1)
    return (w[0] * prev + w[1] * g + w[2] * nxt).reshape(b, t, ch)


def _heads(z):
    return z.reshape(z.shape[:-1] + (A_HEADS, HEAD_DIM))


def _wkv(h, r, k, v, s0, lp):
    f32 = jnp.float32
    b, t, _ = h.shape
    hf = h.astype(f32)
    lw = jnp.tanh(jnp.einsum('btd,edl->betl', hf, lp['decay_down'].astype(f32)))
    w = lp['decay_w0'].astype(f32)[None, :, None, :] + jnp.einsum('betl,elc->betc', lw, lp['decay_up'].astype(f32))
    decay = jnp.exp(-jnp.exp(-jax.nn.softplus(-w) - 0.5))
    la = jnp.einsum('btd,edl->betl', hf, lp['iclr_down'].astype(f32))
    a = jax.nn.sigmoid(lp['iclr_bias'].astype(f32)[None, :, None, :]
                       + jnp.einsum('betl,elc->betc', la, lp['iclr_up'].astype(f32)))
    rf, kf, vf = r.astype(f32), k.astype(f32), v.astype(f32)
    kk = _heads(kf * lp['kk_scale'].astype(f32))
    kk = kk * lax.rsqrt(jnp.maximum(jnp.sum(kk * kk, axis=-1, keepdims=True), 1e-24))
    kd = kf[:, None] * (1.0 + (a - 1.0) * lp['ka_scale'].astype(f32))
    rh, vh, kdh, ah, dh = _heads(rf), _heads(vf), _heads(kd), _heads(a), _heads(decay)

    def both(z):
        return jnp.stack([z, z], axis=1)

    def orient(z):
        return jnp.moveaxis(jnp.stack([z[:, 0], jnp.flip(z[:, 1], axis=1)], axis=1), 2, 0)

    xs = (orient(both(rh)), orient(dh), orient(kdh), orient(both(vh)), orient(both(kk)), orient(ah))

    def step(S, inp):
        r_t, w_t, k_t, v_t, kk_t, a_t = inp
        s_kk = jnp.einsum('bdhij,bdhj->bdhi', S, kk_t)
        S = (S * w_t[..., None, :] - s_kk[..., :, None] * (kk_t * a_t)[..., None, :]
             + v_t[..., :, None] * k_t[..., None, :])
        return S, jnp.einsum('bdhij,bdhj->bdhi', S, r_t)

    s_final, ys = lax.scan(step, s0.astype(f32), xs)
    ys = jnp.moveaxis(ys, 0, 2)
    y = ys[:, 0] + jnp.flip(ys[:, 1], axis=1)
    mean = jnp.mean(y, axis=-1, keepdims=True)
    var = jnp.mean(jnp.square(y - mean), axis=-1, keepdims=True)
    y = ((y - mean) * lax.rsqrt(var + GN_EPS)).reshape(b, t, A_WIDTH)
    y = y * lp['gn_w'].astype(f32) + lp['gn_b'].astype(f32)
    bonus = jnp.sum(rh[:, None] * kdh * _heads(lp['bonus_rk'].astype(f32)), axis=(1, -1))
    y = y + (bonus[..., None] * vh).reshape(b, t, A_WIDTH)
    return y, s_final


def _layer(x, mod, s0, is_latent, lp):
    shift, scale, gate = jnp.split(mod, 3, axis=-1)
    h = _rmsnorm(x, lp['norm_g']) * (1.0 + scale) + shift
    proj = h @ lp['w_in']
    r, k, v, g_a, b_gate, c_gate, u_conv, g_b = jnp.split(proj, IN_SPLITS, axis=-1)
    rkv = _token_shift(jnp.concatenate([r, k, v], axis=-1), lp['shift_mu'].reshape(-1), is_latent)
    r, k, v = jnp.split(rkv, 3, axis=-1)
    ya, s_final = _wkv(h, r, k, v, s0, lp)
    ya = ya.astype(x.dtype) * jax.nn.silu(g_a)
    yb = b_gate * _short_conv(c_gate * u_conv, lp['conv_w'], is_latent) * jax.nn.silu(g_b)
    u = jnp.concatenate([ya, yb], axis=-1) @ lp['w_out']
    return x + gate * u, s_final


def setup_inputs(seed: int = 0) -> dict:
    key = jax.random.key(seed)
    ks = jax.random.split(key, 32)
    f32 = jnp.float32
    L = DEPTH

    def nrm(k, shape, s):
        return jax.random.normal(k, shape, f32) * s

    return {
        "x_prompt": nrm(ks[0], (BATCH, SEQ, D_MODEL), 1.0),
        "x_sample": nrm(ks[1], (DEC_BATCH, DEC_SEQ, D_MODEL), 1.0),
        "c": nrm(ks[2], (DEC_BATCH, D_MODEL), 1.0),
        "state_wkv": nrm(ks[3], (DEC_BATCH, DEPTH, 2, A_HEADS, HEAD_DIM, HEAD_DIM), 0.5),
        "c_ctx": nrm(ks[4], (D_MODEL,), 1.0),
        "w_ada": nrm(ks[5], (L, D_MODEL, 3 * D_MODEL), 0.5 * D_MODEL ** -0.5),
        "b_ada": nrm(ks[6], (L, 3 * D_MODEL), 0.02),
        "norm_g": 1.0 + nrm(ks[7], (L, D_MODEL), 0.02),
        "w_in": nrm(ks[8], (L, D_MODEL, IN_WIDTH), D_MODEL ** -0.5),
        "shift_mu": jax.random.uniform(ks[9], (L, 3, A_WIDTH), f32),
        "decay_w0": jax.random.uniform(ks[10], (L, 2, A_WIDTH), f32, -4.0, 1.0),
        "decay_down": nrm(ks[11], (L, 2, D_MODEL, DECAY_LORA), D_MODEL ** -0.5),
        "decay_up": nrm(ks[12], (L, 2, DECAY_LORA, A_WIDTH), 0.5 * DECAY_LORA ** -0.5),
        "iclr_bias": nrm(ks[13], (L, 2, A_WIDTH), 0.5),
        "iclr_down": nrm(ks[14], (L, 2, D_MODEL, ICLR_LORA), D_MODEL ** -0.5),
        "iclr_up": nrm(ks[15], (L, 2, ICLR_LORA, A_WIDTH), 0.5 * ICLR_LORA ** -0.5),
        "kk_scale": 0.85 + nrm(ks[16], (L, A_WIDTH), 0.05),
        "ka_scale": 1.0 + nrm(ks[17], (L, A_WIDTH), 0.05),
        "bonus_rk": nrm(ks[18], (L, A_WIDTH), 0.1),
        "gn_w": 1.0 + nrm(ks[19], (L, A_WIDTH), 0.02),
        "gn_b": nrm(ks[20], (L, A_WIDTH), 0.02),
        "conv_w": nrm(ks[21], (L, 3, B_WIDTH), 3.0 ** -0.5),
        "w_out": nrm(ks[22], (L, MIX_WIDTH, D_MODEL), MIX_WIDTH ** -0.5),
        "final_g": 1.0 + nrm(ks[23], (D_MODEL,), 0.02),
    }


def reference(x_prompt, x_sample, c, state_wkv, c_ctx, w_ada, b_ada, norm_g, w_in, shift_mu,
              decay_w0, decay_down, decay_up, iclr_bias, iclr_down, iclr_up, kk_scale, ka_scale,
              bonus_rk, gn_w, gn_b, conv_w, w_out, final_g):
    ctx = x_prompt
    lat = x_sample
    ctx_states = []
    for l in range(DEPTH):
        lp = dict(norm_g=norm_g[l], w_in=w_in[l], shift_mu=shift_mu[l], decay_w0=decay_w0[l],
                  decay_down=decay_down[l], decay_up=decay_up[l], iclr_bias=iclr_bias[l],
                  iclr_down=iclr_down[l], iclr_up=iclr_up[l], kk_scale=kk_scale[l],
                  ka_scale=ka_scale[l], bonus_rk=bonus_rk[l], gn_w=gn_w[l], gn_b=gn_b[l],
                  conv_w=conv_w[l], w_out=w_out[l])
        mod_ctx = (jax.nn.silu(c_ctx) @ w_ada[l] + b_ada[l])[None, None, :]
        mod_lat = (jax.nn.silu(c) @ w_ada[l] + b_ada[l])[:, None, :]
        s_zero = jnp.zeros((ctx.shape[0], 2, A_HEADS, HEAD_DIM, HEAD_DIM), jnp.float32)
        ctx, s_ctx = _layer(ctx, mod_ctx, s_zero, False, lp)
        ctx_states.append(s_ctx.astype(x_prompt.dtype))
        lat, _ = _layer(lat, mod_lat, state_wkv[:, l], True, lp)
    y_prompt = _rmsnorm(ctx, final_g)
    y_sample = _rmsnorm(lat, final_g)
    new_state_wkv = jnp.stack(ctx_states, axis=1)
    return (y_prompt, y_sample, new_state_wkv)
```

```cpp
#include <hip/hip_runtime.h>
#include <hip/hip_cooperative_groups.h>
#include <cstdio>
namespace cg = cooperative_groups;

typedef _Float16 h8 __attribute__((ext_vector_type(8)));
typedef _Float16 h4 __attribute__((ext_vector_type(4)));
typedef _Float16 h2 __attribute__((ext_vector_type(2)));
typedef float f2 __attribute__((ext_vector_type(2)));
typedef float f4 __attribute__((ext_vector_type(4)));
typedef float f16v __attribute__((ext_vector_type(16)));

#define NTHREADS 512
constexpr int NT = 40960;
constexpr int NCTX = 8192;
constexpr int DM = 1024;
constexpr int NCAT = 4352;
constexpr int LD1 = 1792;
constexpr int LD2 = 1536;
constexpr int SMEM_BYTES = 139264;

struct Params {
  const float *x_prompt, *x_sample, *c, *state, *c_ctx, *w_ada, *b_ada, *norm_g, *w_in, *shift_mu, *decay_w0,
      *decay_down, *decay_up, *iclr_bias, *iclr_down, *iclr_up, *kk_scale, *ka_scale, *bonus_rk, *gn_w, *gn_b,
      *conv_w, *w_out, *final_g;
  float* out;
  float* MOD;
  _Float16* WCAT;
  _Float16* WOUT;
  _Float16* UPT;
  float* BON;
  _Float16* HY;
  _Float16* P1;
  _Float16* P2;
  unsigned* bar;
};

__device__ __forceinline__ float sigmoidf_(float x) { return __builtin_amdgcn_rcpf(1.f + __expf(-x)); }
__device__ __forceinline__ float siluf_(float x) { return x * sigmoidf_(x); }

template <int CTRL> __device__ __forceinline__ float dpp_add(float x) {
  int y = __builtin_amdgcn_update_dpp(0, __builtin_bit_cast(int, x), CTRL, 0xf, 0xf, true);
  float r = x + __builtin_bit_cast(float, y);
  asm("" : "+v"(r));
  return r;
}
__device__ __forceinline__ float red16(float x) {
  x = dpp_add<0xB1>(x); x = dpp_add<0x4E>(x); x = dpp_add<0x141>(x); x = dpp_add<0x140>(x); return x;
}
__device__ __forceinline__ float red8(float x) {
  x = dpp_add<0xB1>(x); x = dpp_add<0x4E>(x); x = dpp_add<0x141>(x); return x;
}
__device__ __forceinline__ float red64(float x) {
  x = red16(x);
  x += __shfl_xor(x, 16); x += __shfl_xor(x, 32); return x;
}

__device__ __forceinline__ void transpose_tile(const float* __restrict__ src, int ld_src, int k0, int sn0,
                                               _Float16* __restrict__ dst, int ld_dst, int dn0, float* tile, int sn0b = -1) {
  const int tid = threadIdx.x;
#pragma unroll
  for (int rep = 0; rep < 2; ++rep) {
    int idx = tid + rep * NTHREADS; int i = idx >> 4; int j4 = (idx & 15) * 4;
    const int scol = (sn0b >= 0 && j4 >= 32) ? sn0b + (j4 - 32) : sn0 + j4;
    f4 v = __builtin_nontemporal_load((const f4*)(src + (size_t)(k0 + i) * ld_src + scol));
    tile[i * 65 + j4 + 0] = v[0]; tile[i * 65 + j4 + 1] = v[1]; tile[i * 65 + j4 + 2] = v[2]; tile[i * 65 + j4 + 3] = v[3];
  }
  __syncthreads();
  int j = tid >> 3, i8 = (tid & 7) * 8;
  h8 o;
#pragma unroll
  for (int q = 0; q < 8; ++q) o[q] = (_Float16)tile[(i8 + q) * 65 + j];
  const int drow = sn0b >= 0 ? dn0 + 2 * (j & 31) + (j >> 5) : dn0 + j;
  *(h8*)(dst + (size_t)drow * ld_dst + k0 + i8) = o;
  __syncthreads();
}

__device__ __forceinline__ void phase0(const Params& p, unsigned char* smem) {
  int tid = threadIdx.x; asm volatile("" : "+v"(tid));
  const int lane = tid & 63, w = tid >> 6;
  float* fs = (float*)smem;
  for (int item = blockIdx.x; item < 48; item += gridDim.x) {
    float* sc = fs;
    float* red = fs + 9 * 1024;
    for (int idx = tid; idx < 9 * 1024; idx += NTHREADS) {
      int r = idx >> 10, k = idx & 1023;
      float cv = (r == 0) ? p.c_ctx[k] : p.c[(r - 1) * 1024 + k];
      sc[idx] = siluf_(cv);
    }
    __syncthreads();
    const int j0 = item * 64, cq = lane & 15, ks = lane >> 4;
    f4 acc[9];
#pragma unroll
    for (int r = 0; r < 9; ++r) acc[r] = (f4){0.f, 0.f, 0.f, 0.f};
#pragma unroll
    for (int i = 0; i < 32; ++i) {
      int k = w * 128 + i * 4 + ks;
      f4 wv = __builtin_nontemporal_load((const f4*)(p.w_ada + (size_t)k * 3072 + j0 + cq * 4));
#pragma unroll
      for (int r = 0; r < 9; ++r) { float s = sc[r * 1024 + k]; acc[r] += wv * s; }
    }
#pragma unroll
    for (int r = 0; r < 9; ++r)
#pragma unroll
      for (int q = 0; q < 4; ++q) { float v = acc[r][q]; v += __shfl_xor(v, 16); v += __shfl_xor(v, 32); acc[r][q] = v; }
    if (ks == 0) {
#pragma unroll
      for (int r = 0; r < 9; ++r) *(f4*)(red + (w * 9 + r) * 64 + cq * 4) = acc[r];
    }
    __syncthreads();
    for (int idx = tid; idx < 9 * 64; idx += NTHREADS) {
      int r = idx >> 6, cidx = idx & 63;
      float s = p.b_ada[j0 + cidx];
#pragma unroll
      for (int ww = 0; ww < 8; ++ww) s += red[(ww * 9 + r) * 64 + cidx];
      p.MOD[r * 3072 + j0 + cidx] = s;
    }
    __syncthreads();
  }
}

__device__ __forceinline__ void phase_weights(const Params& p, unsigned char* smem) {
  float* fs = (float*)smem;
  for (int t = blockIdx.x; t < 1376; t += gridDim.x) {
    if (t < 1088) {
      int nt = t >> 4, kt = t & 15, n0 = nt * 64;
      if (n0 < 2048) transpose_tile(p.w_in, 4096, kt * 64, n0, p.WCAT, 1024, n0, fs);
      else if (n0 < 3072) transpose_tile(p.w_in, 4096, kt * 64, 2560 + ((n0 - 2048) >> 1), p.WCAT, 1024, n0, fs, 3072 + ((n0 - 2048) >> 1));
      else if (n0 < 4096) transpose_tile(p.w_in, 4096, kt * 64, 2048 + ((n0 - 3072) >> 1), p.WCAT, 1024, n0, fs, 3584 + ((n0 - 3072) >> 1));
      else if (n0 < 4224) transpose_tile(p.decay_down + (size_t)((n0 - 4096) >> 6) * 65536, 64, kt * 64, 0, p.WCAT, 1024, n0, fs);
      else transpose_tile(p.iclr_down + (size_t)((n0 - 4224) >> 6) * 65536, 64, kt * 64, 0, p.WCAT, 1024, n0, fs);
    } else if (t < 1344) {
      int tt = t - 1088, nt = tt >> 4, kt = tt & 15;
      transpose_tile(p.w_out, 1024, kt * 64, nt * 64, p.WOUT, 1024, nt * 64, fs);
    } else {
      int tt = t - 1344, q = tt >> 3, ct = tt & 7, e = q >> 1, which = q & 1;
      const float* src = (which ? p.iclr_up : p.decay_up) + (size_t)e * 64 * 512;
      transpose_tile(src, 512, 0, ct * 64, p.UPT + (size_t)q * 512 * 64, 64, ct * 64, fs);
    }
  }
}

__device__ __forceinline__ void phase1(const Params& p) {
  int tid = threadIdx.x; asm volatile("" : "+v"(tid));
  const int lane = tid & 63, w = tid >> 6;
  f4 gk[4];
#pragma unroll
  for (int i = 0; i < 4; ++i) gk[i] = *(const f4*)(p.norm_g + i * 256 + lane * 4);
  for (int tok0 = blockIdx.x * 8 + w; tok0 < NT / 2; tok0 += gridDim.x * 8) {
    f4 v[2][4]; float ss[2];
#pragma unroll
    for (int u = 0; u < 2; ++u) {
      const int tok = tok0 + u * (NT / 2);
      const float* xr = tok < NCTX ? p.x_prompt + (size_t)tok * DM : p.x_sample + (size_t)(tok - NCTX) * DM;
#pragma unroll
      for (int i = 0; i < 4; ++i) v[u][i] = __builtin_nontemporal_load((const f4*)(xr + i * 256 + lane * 4));
    }
#pragma unroll
    for (int u = 0; u < 2; ++u) {
      float t = 0.f;
#pragma unroll
      for (int i = 0; i < 4; ++i) t += v[u][i][0] * v[u][i][0] + v[u][i][1] * v[u][i][1] + v[u][i][2] * v[u][i][2] + v[u][i][3] * v[u][i][3];
      ss[u] = red64(t);
    }
#pragma unroll
    for (int u = 0; u < 2; ++u) {
      const int tok = tok0 + u * (NT / 2);
      const int mb = tok < NCTX ? 0 : 1 + ((tok - NCTX) >> 12);
      const float rstd = rsqrtf(ss[u] * (1.f / 1024.f) + 1e-6f);
#pragma unroll
      for (int i = 0; i < 4; ++i) {
        int col = i * 256 + lane * 4;
        const f4 g = gk[i];
        f4 sh = *(const f4*)(p.MOD + mb * 3072 + col);
        f4 sc = *(const f4*)(p.MOD + mb * 3072 + 1024 + col);
        h4 o;
#pragma unroll
        for (int q = 0; q < 4; ++q) o[q] = (_Float16)((v[u][i][q] * rstd * g[q]) * (1.f + sc[q]) + sh[q]);
        *(h4*)(p.HY + (size_t)tok * DM + col) = o;
      }
    }
  }
}

template <int EPI>
__device__ __forceinline__ void gemm_phase(const Params& p, const _Float16* __restrict__ A, int lda, const _Float16* __restrict__ Bt,
                           int K, int nMt, int nNt, unsigned char* smem) {
  int tid = threadIdx.x; asm volatile("" : "+v"(tid));
  const int lane = tid & 63, w = tid >> 6, wm = w >> 2, wn = w & 3;
  _Float16* As = (_Float16*)smem;
  _Float16* Bs = As + 2 * 256 * 40;
  const int lrow = tid >> 2, lseg = tid & 3;
  const int G = gridDim.x;
  const bool xcdmap = ((G & 7) == 0) && ((nMt & 31) == 0);
  const int nunits = xcdmap ? (nMt >> 3) * nNt : nMt * nNt;
  const int ustart = xcdmap ? (blockIdx.x >> 3) : blockIdx.x;
  const int ustep = xcdmap ? (G >> 3) : G;
  const int nk = K >> 5;
  const int nmi = nMt >> 3, nfull = nNt >> 3, nrem = nNt & 7, gunits = nmi * 8;
#define UNIT_DECODE(U, MT, NT)                                                                                     \
  if (xcdmap) {                        \
    int mi;                                                                                                       \
    if ((U) < nfull * gunits) { const int g_ = (U) / gunits, r_ = (U) - g_ * gunits, w32 = r_ & 31; mi = (r_ >> 5) * 4 + (w32 >> 3); NT = g_ * 8 + (w32 & 7); } \
    else { const int r_ = (U) - nfull * gunits; mi = r_ / nrem; NT = nfull * 8 + (r_ - mi * nrem); }               \
    MT = (blockIdx.x & 7) + 8 * mi;                                                                               \
  } else { MT = (U) / nNt; NT = (U) % nNt; }
  const size_t astep = (size_t)128 * lda, bstep = (size_t)128 * K;
  h8 ra[4][2], rb[4][2];
#define GEMM_LOAD(S, KT)                                                                           \
    { ra[S][0] = *(const h8*)(ag + (KT) * 32); ra[S][1] = *(const h8*)(ag + astep + (KT) * 32);     \
      rb[S][0] = *(const h8*)(bg + (KT) * 32); rb[S][1] = *(const h8*)(bg + bstep + (KT) * 32); }
  bool preloaded = false;
  for (int u = ustart; u < nunits; u += ustep) {
    int mt_, nt_;
    UNIT_DECODE(u, mt_, nt_)
    const int m0 = mt_ * 256, n0 = nt_ * 256;
    const _Float16* ag = A + (size_t)(m0 + lrow) * lda + lseg * 8;
    const _Float16* bg = Bt + (size_t)(n0 + lrow) * K + lseg * 8;
    f16v acc[4][2];
#pragma unroll
    for (int a = 0; a < 4; ++a)
#pragma unroll
      for (int b = 0; b < 2; ++b)
#pragma unroll
        for (int r = 0; r < 16; ++r) acc[a][b][r] = 0.f;
#define GEMM_STORE(S, BUF)                                                                         \
    { *(h8*)(As + (BUF) * 256 * 40 + lrow * 40 + lseg * 8) = ra[S][0]; *(h8*)(As + (BUF) * 256 * 40 + (lrow + 128) * 40 + lseg * 8) = ra[S][1]; \
      *(h8*)(Bs + (BUF) * 256 * 40 + lrow * 40 + lseg * 8) = rb[S][0]; *(h8*)(Bs + (BUF) * 256 * 40 + (lrow + 128) * 40 + lseg * 8) = rb[S][1]; }
    if (!preloaded) { GEMM_LOAD(0, 0) GEMM_LOAD(1, 1) GEMM_LOAD(2, 2) GEMM_LOAD(3, 3) }
    GEMM_STORE(0, 0)
    __syncthreads();
    const _Float16* Ac = As + (wm * 128 + (lane & 31)) * 40 + (lane >> 5) * 8;
    const _Float16* Bc = Bs + (wn * 64 + (lane & 31)) * 40 + (lane >> 5) * 8;
#define GEMM_COMPUTE(CUR)                                                                                         \
    _Pragma("unroll") for (int ks = 0; ks < 2; ++ks) {                                                            \
      h8 af[4], bf[2];                                                                                            \
      _Pragma("unroll") for (int a = 0; a < 4; ++a) af[a] = *(const h8*)(Ac + (CUR) * 256 * 40 + a * 32 * 40 + ks * 16); \
      _Pragma("unroll") for (int b = 0; b < 2; ++b) bf[b] = *(const h8*)(Bc + (CUR) * 256 * 40 + b * 32 * 40 + ks * 16); \
      _Pragma("unroll") for (int a = 0; a < 4; ++a)                                                               \
        _Pragma("unroll") for (int b = 0; b < 2; ++b)                                                             \
          acc[a][b] = __builtin_amdgcn_mfma_f32_32x32x16_f16(bf[b], af[a], acc[a][b], 0, 0, 0);                   \
    }
    for (int kt = 0; kt < nk; kt += 4) {
#pragma unroll
      for (int s_ = 0; s_ < 4; ++s_) {
        if (kt + s_ + 4 < nk) GEMM_LOAD(s_, kt + s_ + 4)
        GEMM_COMPUTE(s_ & 1)
        if (kt + s_ + 1 < nk) GEMM_STORE((s_ + 1) & 3, (s_ + 1) & 1)
        __syncthreads();
      }
    }
#undef GEMM_COMPUTE
#undef GEMM_STORE
    preloaded = false;
    if (u + ustep < nunits) {
      int mtn, ntn;
      UNIT_DECODE(u + ustep, mtn, ntn)
      const _Float16* agn = A + (size_t)(mtn * 256 + lrow) * lda + lseg * 8;
      const _Float16* bgn = Bt + (size_t)(ntn * 256 + lrow) * K + lseg * 8;
#pragma unroll
      for (int s_ = 0; s_ < 4; ++s_) {
        ra[s_][0] = *(const h8*)(agn + s_ * 32); ra[s_][1] = *(const h8*)(agn + astep + s_ * 32);
        rb[s_][0] = *(const h8*)(bgn + s_ * 32); rb[s_][1] = *(const h8*)(bgn + bstep + s_ * 32);
      }
      preloaded = true;
    }
    if (EPI == 1) {
      _Float16* dst; int ldd, dcol; bool dotanh = false;
      if (nt_ < 6) { dst = p.P1; ldd = LD1; dcol = n0; }
      else if (nt_ < 16) { dst = p.P2; ldd = LD2; dcol = n0 - 1536; }
      else { dst = p.P1; ldd = LD1; dcol = 1536 + (n0 - 4096); dotanh = (wn < 2); }
      _Float16* Cs = (_Float16*)smem + w * (32 * 72);
#pragma unroll
      for (int a = 0; a < 4; ++a) {
#pragma unroll
        for (int b = 0; b < 2; ++b)
#pragma unroll
          for (int rb4 = 0; rb4 < 4; ++rb4) {
            h4 o;
#pragma unroll
            for (int q = 0; q < 4; ++q) {
              float v = acc[a][b][rb4 * 4 + q];
              if (dotanh) v = 1.f - 2.f * __builtin_amdgcn_rcpf(__expf(2.f * v) + 1.f);
              o[q] = (_Float16)v;
            }
            *(h4*)(Cs + (lane & 31) * 72 + b * 32 + rb4 * 8 + (lane >> 5) * 4) = o;
          }
        __syncthreads();
#pragma unroll
        for (int it = 0; it < 4; ++it) {
          int chunk = it * 64 + lane, row = chunk >> 3, c16 = chunk & 7;
          h8 v = *(const h8*)(Cs + row * 72 + c16 * 8);
          *(h8*)(dst + (size_t)(m0 + wm * 128 + a * 32 + row) * ldd + dcol + wn * 64 + c16 * 8) = v;
        }
        __syncthreads();
      }
    } else {
#pragma unroll
      for (int a = 0; a < 4; ++a) {
        const int tok = m0 + wm * 128 + a * 32 + (lane & 31);
        const float* xr = tok < NCTX ? p.x_prompt + (size_t)tok * DM : p.x_sample + (size_t)(tok - NCTX) * DM;
        const int mb = tok < NCTX ? 0 : 1 + ((tok - NCTX) >> 12);
#pragma unroll
        for (int b = 0; b < 2; ++b)
#pragma unroll
          for (int rb4 = 0; rb4 < 4; ++rb4) {
            int col = n0 + wn * 64 + b * 32 + rb4 * 8 + (lane >> 5) * 4;
            f4 xv = *(const f4*)(xr + col);
            f4 gv = *(const f4*)(p.MOD + mb * 3072 + 2048 + col);
            f4 o;
#pragma unroll
            for (int q = 0; q < 4; ++q) o[q] = xv[q] + gv[q] * acc[a][b][rb4 * 4 + q];
            *(f4*)(p.out + (size_t)tok * DM + col) = o;
          }
      }
    }
  }
}

#undef GEMM_LOAD
#undef UNIT_DECODE
namespace pg8 {
#define PG8_LAS __attribute__((address_space(3)))
typedef unsigned short bf16_t;
typedef short bf16x8 __attribute__((ext_vector_type(8)));
typedef _Float16 f16x8 __attribute__((ext_vector_type(8)));
typedef float f32x4 __attribute__((ext_vector_type(4)));
constexpr int BM = 256, BK = 64, HALF = 128, HTB = HALF * BK * 2  , STAGE_BYTES = 8 * HTB, NXCD = 8, WGM = 8;
__device__ __forceinline__ int lds_byte(int r, int c) { const int st = (r >> 4) * 2 + (c >> 5), rr = r & 15, cc = c & 31, ob = rr * 64 + cc * 2; return st * 1024 + (ob ^ (((ob >> 9) & 1) << 5)); }
__device__ __forceinline__ void stage_rc(int b, int& R, int& C) { const int st = b / 1024, sb = b % 1024, swz = sb ^ (((sb >> 9) & 1) << 5); R = (st >> 1) * 16 + swz / 64; C = (st & 1) * 32 + (swz % 64) / 2; }
__device__ __forceinline__ int perm32(int rho) { const int n = rho >> 4, i = rho & 15; return 8 * (i >> 2) + 4 * n + (i & 3); }
struct Unit { int pm, pn; };
struct Gemm { const bf16_t* A; const bf16_t* Bt; int M, N, K, lda; };
struct StaticOrder {
    int nM, nN, nwg, G, c;
    __device__ void init(int M, int N, int G_, int c_) { nM = M / BM; nN = N / BM; nwg = nM * nN; G = G_; c = c_; }
    __device__ bool next(int i, Unit& u) const {
        const long L = (long)i * G + c; if (L >= nwg) return false;
        int wgid = (int)L; { const int q = nwg / NXCD, r = nwg % NXCD, xcd = wgid % NXCD, off = wgid / NXCD; wgid = (xcd < r ? xcd * (q + 1) : r * (q + 1) + (xcd - r) * q) + off; }
        const int nig = WGM * nN, gid = wgid / nig, fm = gid * WGM, gsz = (nM - fm) < WGM ? (nM - fm) : WGM;
        u.pm = fm + ((wgid % nig) % gsz); u.pn = (wgid % nig) / gsz; return true;
    }
    __device__ __forceinline__ void a_ready(const Unit&) const {}
    __device__ __forceinline__ void done(const Unit&) const {}
};
template <class Epi, class Sched>
__device__ __forceinline__ void gemm_phase(PG8_LAS unsigned char* lds, const Gemm g, const Sched& S, const Epi& E) {
    const int tid = threadIdx.x, wid = __builtin_amdgcn_readfirstlane(tid >> 6), lane = tid & 63, wr = wid >> 2, wc = wid & 3, fr = lane & 15, fq = lane >> 4;
    const int K = g.K, nt = K / BK, lda = g.lda;
#define PG8_STAMP() do { } while (0)
    PG8_STAMP();
    unsigned voffA[2], voffB[2];
#pragma unroll
    for (int i = 0; i < 2; ++i) { int R, C; stage_rc(tid * 16 + i * 8192, R, C); const int Rb = Epi::PERM ? ((R & ~31) + perm32(R & 31)) : R;
        voffA[i] = (unsigned)(R * lda + C) * 2u; voffB[i] = (unsigned)(Rb * K + C) * 2u; }
    const size_t kstep = (size_t)(BK * 2);
    const size_t hstep = (size_t)HALF * K * 2, hstepA = (size_t)HALF * lda * 2;
    const size_t tstep = 2 * hstep, tstepA = 2 * hstepA;
    const unsigned ldsw = (unsigned)wid * 1024u;
    const int aoff = lds_byte(wr * 64 + fr, fq * 8), boff = lds_byte(wc * 32 + fr, fq * 8);
#define PG8_SA(b, h) (((b) * 2 + (h)) * HTB)
#define PG8_SB(b, h) ((4 + (b) * 2 + (h)) * HTB)
#define PG8_STAGE(bufoff, gbase, voff) do { _Pragma("unroll") for (int _i = 0; _i < 2; ++_i) \
        __builtin_amdgcn_global_load_lds((const unsigned*)((const char*)(gbase) + (voff)[_i]), (PG8_LAS unsigned*)(lds + (bufoff) + ldsw + _i * 8192), 16, 0, 0); } while (0)
#define PG8_LDA(dst, b, h) do { _Pragma("unroll") for (int m = 0; m < 4; ++m) _Pragma("unroll") for (int k = 0; k < 2; ++k) dst[m][k] = *(const PG8_LAS bf16x8*)(lds + PG8_SA(b, h) + aoff + m * 2048 + k * 1024); } while (0)
#define PG8_LDB(dst, b, h) do { _Pragma("unroll") for (int n = 0; n < 2; ++n) _Pragma("unroll") for (int k = 0; k < 2; ++k) dst[n][k] = *(const PG8_LAS bf16x8*)(lds + PG8_SB(b, h) + boff + n * 2048 + k * 1024); } while (0)
#define PG8_MMA(ai, bj, At, Bt) do { __builtin_amdgcn_s_setprio(1); _Pragma("unroll") for (int m = 0; m < 4; ++m) _Pragma("unroll") for (int n = 0; n < 2; ++n) _Pragma("unroll") for (int k = 0; k < 2; ++k) \
        acc[ai][bj][m][n] = __builtin_amdgcn_mfma_f32_16x16x32_f16(__builtin_bit_cast(f16x8, Bt[n][k]), __builtin_bit_cast(f16x8, At[m][k]), acc[ai][bj][m][n], 0, 0, 0); __builtin_amdgcn_s_setprio(0); } while (0)
#define PG8_WAIT_V(n) asm volatile("s_waitcnt vmcnt(" #n ")" ::: "memory")
#define PG8_WAIT_L(n) asm volatile("s_waitcnt lgkmcnt(" #n ")" ::: "memory")
#define PG8_BAR __builtin_amdgcn_s_barrier()
#define PG8_SCHED __builtin_amdgcn_sched_barrier(0)
    Unit cur, nxt; int ui = 0;
    if (!S.next(0, cur)) return;
    f32x4 acc[2][2][4][2];
#pragma unroll
    for (int a = 0; a < 2; ++a)
#pragma unroll
        for (int b = 0; b < 2; ++b)
#pragma unroll
            for (int m = 0; m < 4; ++m)
#pragma unroll
                for (int n = 0; n < 2; ++n) acc[a][b][m][n] = (f32x4){0.f, 0.f, 0.f, 0.f};
    bf16x8 At[4][2], B0[2][2], B1[2][2];
    const char* cA = (const char*)g.A + (size_t)cur.pm * tstepA; const char* cB = (const char*)g.Bt + (size_t)cur.pn * tstep;
    S.a_ready(cur);
    PG8_STAGE(PG8_SB(0, 0), cB, voffB); PG8_STAGE(PG8_SA(0, 0), cA, voffA); PG8_STAGE(PG8_SB(0, 1), cB + hstep, voffB); PG8_STAGE(PG8_SA(0, 1), cA + hstepA, voffA);
    if (wr == 1) PG8_BAR;
    PG8_WAIT_V(4); PG8_BAR;
    PG8_STAGE(PG8_SB(1, 0), cB + kstep, voffB); PG8_STAGE(PG8_SA(1, 0), cA + kstep, voffA); PG8_STAGE(PG8_SB(1, 1), cB + hstep + kstep, voffB);
    PG8_WAIT_V(6); PG8_BAR;
    PG8_STAMP();
    for (;;) {
        const bool has_next = S.next(ui + 1, nxt);
        const char* nA = has_next ? (const char*)g.A + (size_t)nxt.pm * tstepA : cA; const char* nB = has_next ? (const char*)g.Bt + (size_t)nxt.pn * tstep : cB;
        for (int t = 0; t < nt; t += 2) {
            const bool last = (t == nt - 2);
            const char* a1 = cA + (size_t)(t + 1) * kstep;
            const char* a2 = last ? nA : cA + (size_t)(t + 2) * kstep; const char* b2 = last ? nB : cB + (size_t)(t + 2) * kstep;
            const char* a3 = a2 + kstep; const char* b3 = b2 + kstep;
            if (last && has_next) S.a_ready(nxt);
            PG8_LDB(B0, 0, 0); PG8_SCHED; PG8_LDA(At, 0, 0); PG8_STAGE(PG8_SA(1, 1), a1 + hstepA, voffA);
            PG8_WAIT_L(8); PG8_BAR; PG8_WAIT_L(0); PG8_MMA(0, 0, At, B0); PG8_BAR; PG8_SCHED;
            PG8_LDB(B1, 0, 1); PG8_STAGE(PG8_SB(0, 0), b2, voffB);
            PG8_BAR; PG8_WAIT_L(0); PG8_MMA(0, 1, At, B1); PG8_BAR;
            PG8_LDA(At, 0, 1); PG8_STAGE(PG8_SA(0, 0), a2, voffA);
            PG8_BAR; PG8_WAIT_L(0); PG8_MMA(1, 0, At, B0); PG8_BAR; PG8_SCHED;
            PG8_STAGE(PG8_SB(0, 1), b2 + hstep, voffB);
            PG8_WAIT_V(6); PG8_BAR; PG8_MMA(1, 1, At, B1); PG8_BAR;
            PG8_LDB(B0, 1, 0); PG8_SCHED; PG8_LDA(At, 1, 0); PG8_STAGE(PG8_SA(0, 1), a2 + hstepA, voffA);
            PG8_WAIT_L(8); PG8_BAR; PG8_WAIT_L(0); PG8_MMA(0, 0, At, B0); PG8_BAR; PG8_SCHED;
            PG8_LDB(B1, 1, 1); PG8_STAGE(PG8_SB(1, 0), b3, voffB);
            PG8_BAR; PG8_WAIT_L(0); PG8_MMA(0, 1, At, B1); PG8_BAR;
            PG8_LDA(At, 1, 1); PG8_STAGE(PG8_SA(1, 0), a3, voffA);
            PG8_BAR; PG8_WAIT_L(0); PG8_MMA(1, 0, At, B0); PG8_BAR; PG8_SCHED;
            PG8_STAGE(PG8_SB(1, 1), b3 + hstep, voffB);
            PG8_WAIT_V(6); PG8_BAR; PG8_MMA(1, 1, At, B1); PG8_BAR;
        }
        PG8_STAMP();
        if constexpr (!Epi::AFTER_DRAIN) { E(acc, cur, wr, wc, fr, fq); S.done(cur); }
        PG8_STAMP();
        if (!has_next) break;
#pragma unroll
        for (int a = 0; a < 2; ++a)
#pragma unroll
            for (int b = 0; b < 2; ++b)
#pragma unroll
                for (int m = 0; m < 4; ++m)
#pragma unroll
                    for (int n = 0; n < 2; ++n) acc[a][b][m][n] = (f32x4){0.f, 0.f, 0.f, 0.f};
        cur = nxt; cA = nA; cB = nB; ++ui;
    }
    PG8_WAIT_V(0);
    if (wr == 0) PG8_BAR;
    PG8_BAR;
    if constexpr (Epi::AFTER_DRAIN) { E.fused(acc, cur, wr, wc, fr, fq, lds, wid, lane); S.done(cur); }
    PG8_STAMP();
#undef PG8_STAMP
#undef PG8_SA
#undef PG8_SB
#undef PG8_STAGE
#undef PG8_LDA
#undef PG8_LDB
#undef PG8_MMA
#undef PG8_WAIT_V
#undef PG8_WAIT_L
#undef PG8_BAR
#undef PG8_SCHED
}
}

struct EpiProj {
  static constexpr bool PERM = true, AFTER_DRAIN = false;
  _Float16* P1; _Float16* P2;
  __device__ __forceinline__ void operator()(const pg8::f32x4 (&acc)[2][2][4][2], const pg8::Unit& u, int wr, int wc, int fr, int fq) const {
    const int row0 = u.pm * 256 + wr * 64 + fr;
    if (u.pn >= 8 && u.pn < 16) {
      const bool cu = u.pn < 12;
      const int dcol = (cu ? 1024 + ((u.pn - 8) * 128) : 512 + ((u.pn - 12) * 128)) + wc * 16 + 4 * fq;
#pragma unroll
      for (int ai = 0; ai < 2; ++ai)
#pragma unroll
        for (int m = 0; m < 4; ++m) {
          _Float16* rowp = P2 + (size_t)(row0 + ai * 128 + m * 16) * LD2 + dcol;
#pragma unroll
          for (int bj = 0; bj < 2; ++bj) {
            h4 o;
#pragma unroll
            for (int q = 0; q < 4; ++q) {
              const float x0 = acc[ai][bj][m][q >> 1][(q & 1) * 2], x1 = acc[ai][bj][m][q >> 1][(q & 1) * 2 + 1];
              o[q] = (_Float16)(cu ? x0 * x1 : x0 * siluf_(x1));
            }
            __builtin_nontemporal_store(o, (h4*)(rowp + bj * 64));
          }
        }
      return;
    }
    _Float16* dst; int ldd, dcol; bool tanh0 = false;
    if (u.pn < 6) { dst = P1; ldd = LD1; dcol = u.pn * 256; }
    else if (u.pn < 8) { dst = P2; ldd = LD2; dcol = u.pn * 256 - 1536; }
    else { dst = P1; ldd = LD1; dcol = 1536; tanh0 = true; }
    const int col0 = dcol + wc * 32 + 8 * fq;
#pragma unroll
    for (int ai = 0; ai < 2; ++ai)
#pragma unroll
      for (int m = 0; m < 4; ++m) {
        _Float16* rowp = dst + (size_t)(row0 + ai * 128 + m * 16) * ldd + col0;
#pragma unroll
        for (int bj = 0; bj < 2; ++bj) {
          h8 o;
#pragma unroll
          for (int q = 0; q < 8; ++q) {
            float v = acc[ai][bj][m][q >> 2][q & 3];
            if (tanh0 && bj == 0) v = 1.f - 2.f * __builtin_amdgcn_rcpf(__expf(2.f * v) + 1.f);
            o[q] = (_Float16)v;
          }
          if (dst == P2) __builtin_nontemporal_store(o, (h8*)(rowp + bj * 128)); else *(h8*)(rowp + bj * 128) = o;
        }
      }
  }
};
struct EpiOut {
  static constexpr bool PERM = true, AFTER_DRAIN = false;
  const float* x_prompt; const float* x_sample; const float* MOD; _Float16* Z;
  __device__ __forceinline__ void operator()(const pg8::f32x4 (&acc)[2][2][4][2], const pg8::Unit& u, int wr, int wc, int fr, int fq) const {
    const int m0 = u.pm * 256;
    const float* xbase = m0 < NCTX ? x_prompt + (size_t)m0 * DM : x_sample + (size_t)(m0 - NCTX) * DM;
    _Float16* zbase = Z + (size_t)m0 * DM;
    const int mb = m0 < NCTX ? 0 : 1 + ((m0 - NCTX) >> 12);
    const unsigned col0 = (unsigned)(u.pn * 256 + wc * 32 + 8 * fq);
    const float* gp = MOD + mb * 3072 + 2048;
    const unsigned row0 = (unsigned)(wr * 64 + fr);
#pragma unroll
    for (int ai = 0; ai < 2; ++ai)
#pragma unroll
      for (int m = 0; m < 4; ++m) {
        const unsigned ro = (row0 + ai * 128 + m * 16) * DM + col0;
#pragma unroll
        for (int bj = 0; bj < 2; ++bj) {
          const f4 x0 = __builtin_nontemporal_load((const f4*)(xbase + (ro + bj * 128))), x1 = __builtin_nontemporal_load((const f4*)(xbase + (ro + bj * 128 + 4)));
          const f4 g0 = *(const f4*)(gp + (col0 + bj * 128)), g1 = *(const f4*)(gp + (col0 + bj * 128 + 4));
          const f4 z0 = x0 + g0 * acc[ai][bj][m][0], z1 = x1 + g1 * acc[ai][bj][m][1];
          h8 o;
#pragma unroll
          for (int q = 0; q < 4; ++q) { o[q] = (_Float16)z0[q]; o[4 + q] = (_Float16)z1[q]; }
          *(h8*)(zbase + (ro + bj * 128)) = o;
        }
      }
  }
};

constexpr int SC_S = 0, SC_W = 2 * 5 * 2048, SC_A = SC_W + 4 * 2048, SC_Y = SC_A + 2 * 2048, SC_C = SC_Y + 1024, SC_G = SC_C + 384, SC_END = SC_G + 256;
template <int DIR>
__device__ __forceinline__ void scan_item(const Params& p, bool is_lat, int b, int h, int half, unsigned char* smem) {
  constexpr int e = DIR;
  int t0 = threadIdx.x; asm volatile("" : "+v"(t0));
  const int w = __builtin_amdgcn_readfirstlane(t0 >> 6);
  const int lane = t0 & 63;
  float* Sb = (float*)smem + SC_S;
  float* Wb = (float*)smem + SC_W;
  float* Ab = (float*)smem + SC_A;
  _Float16* Yb = (_Float16*)((float*)smem + SC_Y);
  float* Cb = (float*)smem + SC_C;
  float* Gb = (float*)smem + SC_G;
  const int T = is_lat ? 4096 : 256;
  const int RLm = is_lat ? 63 : 255;
  const int tok0 = is_lat ? NCTX + b * 4096 : b * 256;
  const int nch = T >> 5;
  if (t0 < 384) {
    const int arr = t0 >> 6, cc = t0 & 63;
    const float* src = arr < 3 ? p.shift_mu + arr * 512 : (arr == 3 ? p.kk_scale : (arr == 4 ? p.ka_scale : p.bonus_rk));
    Cb[t0] = src[h * 64 + cc];
  }
  const int rl = (w & 3) * 8 + (lane >> 3);
  const int irow = half * 32 + rl;
  const int g = lane & 7;
  f2 S0 = (f2){0.f, 0.f}, S1 = S0, S2 = S0, S3 = S0;
  if (is_lat && w < 4) {
    const float* sp = p.state + ((size_t)((b * 2 + e) * 8 + h)) * 4096 + irow * 64 + g * 8;
    f4 s0 = *(const f4*)(sp), s1 = *(const f4*)(sp + 4);
    S0 = (f2){s0[0], s0[1]}; S1 = (f2){s0[2], s0[3]}; S2 = (f2){s1[0], s1[1]}; S3 = (f2){s1[2], s1[3]};
  }
  const int yq = (t0 & 255) >> 3, yr4 = (t0 & 7) * 4;
  _Float16* yout = p.HY + ((size_t)e * NT + tok0 + yq) * 512 + h * 64 + half * 32 + yr4;
  const int pt = t0 & 255;
  const int eq = pt >> 3, ecg = pt & 7;
  const int hc = h * 64 + ecg * 8;
  const int which = w & 1, tt = (w >> 1) & 1;
  h8 pr[3][3];
  h8 pa[2];
  h8 bfr[4][2];
  float bias[4];
  if (w >= 4) {
    const unsigned uoff = (unsigned)(((e * 2 + which) * 512 + h * 64 + (lane & 15)) * 64 + (lane >> 4) * 8);
    const float* bp = (which ? p.iclr_bias : p.decay_w0) + (unsigned)(e * 512 + h * 64 + (lane & 15));
#pragma unroll
    for (int ct = 0; ct < 4; ++ct) {
      bfr[ct][0] = *(const h8*)(p.UPT + (uoff + ct * 16 * 64));
      bfr[ct][1] = *(const h8*)(p.UPT + (uoff + ct * 16 * 64 + 32));
      bias[ct] = bp[ct * 16];
    }
  }
#define TB_OF(C) (DIR == 0 ? (C) * 32 : T - 32 - (C) * 32)
#define PREFETCH_PA(C)                                                                             \
  { const unsigned aoff_ = (unsigned)((tok0 + TB_OF(C) + tt * 16 + (lane & 15)) * LD1 + 1536 + which * 128 + e * 64 + (lane >> 4) * 8); \
    pa[0] = *(const h8*)(p.P1 + aoff_); pa[1] = *(const h8*)(p.P1 + (aoff_ + 32)); }
#define PREFETCH_PR(C)                                                                             \
  { const int t_ = TB_OF(C) + eq;                                                                  \
    const unsigned off_ = (unsigned)((tok0 + t_) * LD1 + hc);                                      \
    const bool pv_ = (t_ & RLm) != 0, nv_ = (t_ & RLm) != RLm;                                     \
    _Pragma("unroll") for (int s_ = 0; s_ < 3; ++s_) {                                             \
      pr[s_][0] = *(const h8*)(p.P1 + (off_ + s_ * 512));                                          \
      pr[s_][1] = pv_ ? *(const h8*)(p.P1 + (off_ + s_ * 512 - LD1)) : (h8){0, 0, 0, 0, 0, 0, 0, 0}; \
      pr[s_][2] = nv_ ? *(const h8*)(p.P1 + (off_ + s_ * 512 + LD1)) : (h8){0, 0, 0, 0, 0, 0, 0, 0}; \
    } }
  if (w >= 4) PREFETCH_PA(0)
  __syncthreads();
#pragma unroll 1
  for (int i = 0; i < nch + 2; ++i) {
    if (w >= 4) {
      if (i < nch) {
        float* lamb = Wb + (i & 1) * 2048;
        float* wlb = Wb + 4096 + (i & 1) * 2048;
        float* ab_ = Ab + (i & 1) * 2048;
        const int G_ = lane >> 4;
#pragma unroll
        for (int ct = 0; ct < 4; ++ct) {
          f4 acc = (f4){0.f, 0.f, 0.f, 0.f};
          acc = __builtin_amdgcn_mfma_f32_16x16x32_f16(pa[0], bfr[ct][0], acc, 0, 0, 0);
          acc = __builtin_amdgcn_mfma_f32_16x16x32_f16(pa[1], bfr[ct][1], acc, 0, 0, 0);
          if (which) {
#pragma unroll
            for (int r = 0; r < 4; ++r) ab_[(tt * 16 + G_ * 4 + r) * 64 + ct * 16 + (lane & 15)] = sigmoidf_(acc[r] + bias[ct]);
          } else {
            float wl[4], lam[4];
#pragma unroll
            for (int r = 0; r < 4; ++r) wl[r] = -0.8750387749f * sigmoidf_(acc[r] + bias[ct]);
            if (DIR == 0) { lam[0] = wl[0]; lam[1] = lam[0] + wl[1]; lam[2] = lam[1] + wl[2]; lam[3] = lam[2] + wl[3]; }
            else { lam[3] = wl[3]; lam[2] = lam[3] + wl[2]; lam[1] = lam[2] + wl[1]; lam[0] = lam[1] + wl[0]; }
            const float tot = DIR == 0 ? lam[3] : lam[0];
            const float t0_ = __shfl(tot, (lane & 15)), t1_ = __shfl(tot, (lane & 15) + 16), t2_ = __shfl(tot, (lane & 15) + 32), t3_ = __shfl(tot, (lane & 15) + 48);
            float E_;
            if (DIR == 0) E_ = (G_ > 0 ? t0_ : 0.f) + (G_ > 1 ? t1_ : 0.f) + (G_ > 2 ? t2_ : 0.f);
            else E_ = (G_ < 1 ? t1_ : 0.f) + (G_ < 2 ? t2_ : 0.f) + (G_ < 3 ? t3_ : 0.f);
#pragma unroll
            for (int r = 0; r < 4; ++r) {
              const int o_ = (tt * 16 + G_ * 4 + r) * 64 + ct * 16 + (lane & 15);
              lamb[o_] = E_ + lam[r]; wlb[o_] = wl[r];
            }
          }
        }
        if (i + 1 < nch) PREFETCH_PA(i + 1)
      }
      if (i >= 1 && i <= nch) {
        const int c = i - 1;
        const float* cb = Cb + ecg * 8;
        const float* ab = Ab + (c & 1) * 2048 + eq * 64 + ecg * 8;
        const float* lmb = Wb + (c & 1) * 2048 + eq * 64 + ecg * 8;
        const float* wlb = Wb + 4096 + (c & 1) * 2048 + eq * 64 + ecg * 8;
        const bool glast = DIR == 0 ? ((eq & 15) == 15) : ((eq & 15) == 0);
        float* o0 = Sb + (c & 1) * 10240 + eq * 64 + ecg * 8;
        float ksft[8], ssq = 0.f;
#pragma unroll
        for (int q = 0; q < 8; ++q) {
          const float x = (float)pr[1][0][q], xp = (float)pr[1][1][q], xn = (float)pr[1][2][q];
          ksft[q] = x + cb[64 + q] * (0.5f * (xp + xn) - x);
          const float kkr = ksft[q] * cb[192 + q];
          ssq += kkr * kkr;
        }
        ssq = red8(ssq);
        const float rn = rsqrtf(fmaxf(ssq, 1e-24f));
        float bo = 0.f;
#pragma unroll
        for (int hq = 0; hq < 2; ++hq) {
          f4 kk, bb, kd, rs, vs;
          const f4 a4 = *(const f4*)(ab + hq * 4);
          const f4 lm4 = *(const f4*)(lmb + hq * 4), wl4 = *(const f4*)(wlb + hq * 4);
          f4 gcur4;
#pragma unroll
          for (int qq = 0; qq < 4; ++qq) {
            const int q = hq * 4 + qq;
            float x = (float)pr[0][0][q], xp = (float)pr[0][1][q], xn = (float)pr[0][2][q];
            rs[qq] = x + cb[q] * (0.5f * (xp + xn) - x);
            x = (float)pr[2][0][q]; xp = (float)pr[2][1][q]; xn = (float)pr[2][2][q];
            vs[qq] = x + cb[128 + q] * (0.5f * (xp + xn) - x);
            const float kkv = ksft[q] * cb[192 + q] * rn;
            const float kdv = ksft[q] * (1.f + (a4[qq] - 1.f) * cb[256 + q]);
            bo += rs[qq] * kdv * cb[320 + q];
            const float gprev = __builtin_amdgcn_exp2f(lm4[qq] - wl4[qq]), ginv = __builtin_amdgcn_exp2f(-lm4[qq]), gcur = __builtin_amdgcn_exp2f(lm4[qq]);
            kk[qq] = kkv * gprev; bb[qq] = kkv * a4[qq] * ginv; kd[qq] = kdv * ginv; rs[qq] *= gcur; gcur4[qq] = gcur;
          }
          *(f4*)(o0 + hq * 4) = kk;
          *(f4*)(o0 + 2048 + hq * 4) = bb;
          *(f4*)(o0 + 4096 + hq * 4) = kd;
          *(f4*)(o0 + 6144 + hq * 4) = rs;
          *(f4*)(o0 + 8192 + hq * 4) = vs;
          if (glast) *(f4*)(Gb + (c & 1) * 128 + (eq >> 4) * 64 + ecg * 8 + hq * 4) = gcur4;
        }
        bo = red8(bo);
        if (half == 0 && ecg == 0) p.BON[(unsigned)((e * NT + tok0 + TB_OF(c) + eq) * 8 + h)] = bo;
      }
      if (i < nch) PREFETCH_PR(i)
    } else {
      if (i >= 3) *(h4*)(yout + (size_t)TB_OF(i - 3) * 512) = *(const h4*)(Yb + ((i - 3) & 1) * 1024 + yq * 32 + yr4);
      if (i >= 2) {
        const int c = i - 2;
        const float* Sc = Sb + (c & 1) * 10240;
        const float* Gc = Gb + (c & 1) * 128;
        _Float16* Yc = Yb + (c & 1) * 1024;
#pragma unroll 1
        for (int so = 0; so < 2; ++so) {
          const int qb = DIR == 0 ? so * 16 : 16 - so * 16;
          const float* Lb = Sc + qb * 64 + g * 8;
          const float* Lv = Sc + 8192 + qb * 64 + irow;
#define STEP_OFF(SI) ((DIR == 0 ? (SI) : 15 - (SI)) * 64)
          float cY = 0.f;
          f4 ka = *(const f4*)(Lb + STEP_OFF(0)), kb = *(const f4*)(Lb + 4 + STEP_OFF(0));
          f4 ba = *(const f4*)(Lb + 2048 + STEP_OFF(0)), bb_ = *(const f4*)(Lb + 2048 + 4 + STEP_OFF(0));
          f4 da = *(const f4*)(Lb + 4096 + STEP_OFF(0)), db = *(const f4*)(Lb + 4096 + 4 + STEP_OFF(0));
          f4 ra = *(const f4*)(Lb + 6144 + STEP_OFF(0)), rb_ = *(const f4*)(Lb + 6144 + 4 + STEP_OFF(0));
          float vv = Lv[STEP_OFF(0)];
#pragma unroll
          for (int si = 0; si < 16; ++si) {
            f4 nka, nkb, nba, nbb, nda, ndb, nra, nrb; float nvv;
            if (si < 15) {
              const int o = STEP_OFF(si + 1);
              nka = *(const f4*)(Lb + o); nkb = *(const f4*)(Lb + 4 + o);
              nba = *(const f4*)(Lb + 2048 + o); nbb = *(const f4*)(Lb + 2048 + 4 + o);
              nda = *(const f4*)(Lb + 4096 + o); ndb = *(const f4*)(Lb + 4096 + 4 + o);
              nra = *(const f4*)(Lb + 6144 + o); nrb = *(const f4*)(Lb + 6144 + 4 + o);
              nvv = Lv[o];
            }
            f2 dk = S0 * (f2){ka[0], ka[1]} + S1 * (f2){ka[2], ka[3]} + S2 * (f2){kb[0], kb[1]} + S3 * (f2){kb[2], kb[3]};
            const float sk = red8(dk[0] + dk[1]);
            const f2 nk2 = (f2){-sk, -sk}, v2_ = (f2){vv, vv};
            S0 = S0 + nk2 * (f2){ba[0], ba[1]} + v2_ * (f2){da[0], da[1]};
            S1 = S1 + nk2 * (f2){ba[2], ba[3]} + v2_ * (f2){da[2], da[3]};
            S2 = S2 + nk2 * (f2){bb_[0], bb_[1]} + v2_ * (f2){db[0], db[1]};
            S3 = S3 + nk2 * (f2){bb_[2], bb_[3]} + v2_ * (f2){db[2], db[3]};
            f2 dy = S0 * (f2){ra[0], ra[1]} + S1 * (f2){ra[2], ra[3]} + S2 * (f2){rb_[0], rb_[1]} + S3 * (f2){rb_[2], rb_[3]};
            const float yv = red8(dy[0] + dy[1]);
            cY = (g == (si & 7)) ? yv : cY;
            if ((si & 7) == 7) {
              const int st = so * 16 + (si - 7) + g;
              const int qq = DIR == 0 ? st : 31 - st;
              Yc[qq * 32 + rl] = (_Float16)(cY * 0.0625f);
            }
            if (si < 15) { ka = nka; kb = nkb; ba = nba; bb_ = nbb; da = nda; db = ndb; ra = nra; rb_ = nrb; vv = nvv; }
          }
#undef STEP_OFF
          { const f4 ga = *(const f4*)(Gc + (qb >> 4) * 64 + g * 8), gb = *(const f4*)(Gc + (qb >> 4) * 64 + g * 8 + 4);
            S0 = S0 * (f2){ga[0], ga[1]}; S1 = S1 * (f2){ga[2], ga[3]}; S2 = S2 * (f2){gb[0], gb[1]}; S3 = S3 * (f2){gb[2], gb[3]}; }
        }
      }
    }
    __syncthreads();
  }
  if (w < 4) {
    *(h4*)(yout + (size_t)TB_OF(nch - 1) * 512) = *(const h4*)(Yb + ((nch - 1) & 1) * 1024 + yq * 32 + yr4);
    if (!is_lat) {
      float* op = p.out + (size_t)NT * DM + ((size_t)((b * 2 + e) * 8 + h)) * 4096 + irow * 64 + g * 8;
      *(f4*)(op) = (f4){S0[0], S0[1], S1[0], S1[1]};
      *(f4*)(op + 4) = (f4){S2[0], S2[1], S3[0], S3[1]};
    }
  }
#undef TB_OF
#undef PREFETCH_PA
#undef PREFETCH_PR
  __syncthreads();
}

template <int DIR>
__device__ __forceinline__ void scan_stream2(const Params& p, int cbase, int h, int half, unsigned char* smem) {
  constexpr int e = DIR;
  int t0 = threadIdx.x; asm volatile("" : "+v"(t0));
  const int w = __builtin_amdgcn_readfirstlane(t0 >> 6);
  const int lane = t0 & 63;
  float* Sb = (float*)smem + SC_S;
  float* Wb = (float*)smem + SC_W;
  float* Ab = (float*)smem + SC_A;
  _Float16* Yb = (_Float16*)((float*)smem + SC_Y);
  float* Cb = (float*)smem + SC_C;
  _Float16* Ch = (_Float16*)((float*)smem + SC_END);
  float* Gb = (float*)smem + SC_G;
  constexpr int NCHUNK = 128 + 4 * 8;
#define CD_LAT(N) ((N) < 128)
#define CD_C(N) (CD_LAT(N) ? (N) : (((N) - 128) & 7))
#define CD_B(N) (((CD_LAT(N) ? 0 : ((((N) - 128) >> 3) * 128)) + cbase) >> 4)
#define CD_T(N) (CD_LAT(N) ? 4096 : 256)
#define CD_RLM(N) (CD_LAT(N) ? 63 : 255)
#define CD_TOK0(N) (CD_LAT(N) ? NCTX + CD_B(N) * 4096 : CD_B(N) * 256)
#define CD_FIRST(N) (CD_C(N) == 0)
#define CD_LAST(N) (CD_C(N) == (CD_LAT(N) ? 127 : 7))
  if (t0 < 384) {
    const int arr = t0 >> 6, cc = t0 & 63;
    const float* src = arr < 3 ? p.shift_mu + arr * 512 : (arr == 3 ? p.kk_scale : (arr == 4 ? p.ka_scale : p.bonus_rk));
    const float cv_ = src[h * 64 + cc];
    Cb[t0] = cv_;
    if (arr < 3) Ch[t0] = (_Float16)cv_;
  }
  const int rl = (w & 3) * 8 + (lane >> 3);
  const int irow = half * 32 + rl;
  const int g = lane & 7;
  f2 S0 = (f2){0.f, 0.f}, S1 = S0, S2 = S0, S3 = S0;
  const int yq = (t0 & 255) >> 3, yr4 = (t0 & 7) * 4;
  _Float16* yout = p.HY + ((size_t)e * NT + yq) * 512 + h * 64 + half * 32 + yr4;
  const int pt = t0 & 255;
  const int eq = pt >> 3, ecg = pt & 7;
  const int hc = h * 64 + ecg * 8;
  const int tt = w & 1, cp = (w >> 1) & 1;
  h8 pr[3][3];
  h8 pa[2][2];
  h8 bfr[2][2][2];
  float bias[2][2];
  if (w >= 4) {
#pragma unroll
    for (int wh = 0; wh < 2; ++wh) {
      const unsigned uoff = (unsigned)(((e * 2 + wh) * 512 + h * 64 + cp * 32 + (lane & 15)) * 64 + (lane >> 4) * 8);
      const float* bp = (wh ? p.iclr_bias : p.decay_w0) + (unsigned)(e * 512 + h * 64 + cp * 32 + (lane & 15));
#pragma unroll
      for (int c2 = 0; c2 < 2; ++c2) {
        bfr[wh][c2][0] = *(const h8*)(p.UPT + (uoff + c2 * 16 * 64));
        bfr[wh][c2][1] = *(const h8*)(p.UPT + (uoff + c2 * 16 * 64 + 32));
        bias[wh][c2] = bp[c2 * 16];
      }
    }
  }
#define TB_OF(N) (DIR == 0 ? CD_C(N) * 32 : CD_T(N) - 32 - CD_C(N) * 32)
#define PREFETCH_PA(C)                                                                             \
  { const unsigned aoff_ = (unsigned)((CD_TOK0(C) + TB_OF(C) + tt * 16 + (lane & 15)) * LD1 + 1536 + e * 64 + (lane >> 4) * 8); \
    pa[0][0] = *(const h8*)(p.P1 + aoff_); pa[0][1] = *(const h8*)(p.P1 + (aoff_ + 32));                                    \
    pa[1][0] = *(const h8*)(p.P1 + (aoff_ + 128)); pa[1][1] = *(const h8*)(p.P1 + (aoff_ + 160)); }
#define PREFETCH_PR(C)                                                                             \
  { const int t_ = TB_OF(C) + eq;                                                                  \
    const unsigned off_ = (unsigned)((CD_TOK0(C) + t_) * LD1 + hc);                                \
    const bool pv_ = (t_ & CD_RLM(C)) != 0, nv_ = (t_ & CD_RLM(C)) != CD_RLM(C);                   \
    _Pragma("unroll") for (int s_ = 0; s_ < 3; ++s_) {                                             \
      pr[s_][0] = *(const h8*)(p.P1 + (off_ + s_ * 512));                                          \
      pr[s_][1] = pv_ ? *(const h8*)(p.P1 + (off_ + s_ * 512 - LD1)) : (h8){0, 0, 0, 0, 0, 0, 0, 0}; \
      pr[s_][2] = nv_ ? *(const h8*)(p.P1 + (off_ + s_ * 512 + LD1)) : (h8){0, 0, 0, 0, 0, 0, 0, 0}; \
    } }
  if (w >= 4) PREFETCH_PA(0)
  __syncthreads();
#pragma unroll 1
  for (int i = 0; i < NCHUNK + 2; ++i) {
    if (w >= 4) {
      if (i < NCHUNK) {
        const int G_ = lane >> 4;
        const int rowbase = (tt * 16 + G_ * 4) * 64 + cp * 32 + (lane & 15);
        float* lp = Wb + (i & 1) * 2048 + rowbase;
        float* wp = Wb + 4096 + (i & 1) * 2048 + rowbase;
        float* ap = Ab + (i & 1) * 2048 + rowbase;
#define SIG2(X, OUT) { const f2 t_ = (X) * (f2){-1.44269504f, -1.44269504f};                                       \
                       const f2 e_ = (f2){__builtin_amdgcn_exp2f(t_[0]), __builtin_amdgcn_exp2f(t_[1])} + (f2){1.f, 1.f}; \
                       OUT = (f2){__builtin_amdgcn_rcpf(e_[0]), __builtin_amdgcn_rcpf(e_[1])}; }
#pragma unroll
        for (int c2 = 0; c2 < 2; ++c2) {
          {
            f4 acc = (f4){0.f, 0.f, 0.f, 0.f};
            acc = __builtin_amdgcn_mfma_f32_16x16x32_f16(pa[1][0], bfr[1][c2][0], acc, 0, 0, 0);
            acc = __builtin_amdgcn_mfma_f32_16x16x32_f16(pa[1][1], bfr[1][c2][1], acc, 0, 0, 0);
            const f2 bb2 = (f2){bias[1][c2], bias[1][c2]};
            f2 s01, s23;
            SIG2(((f2){acc[0], acc[1]} + bb2), s01)
            SIG2(((f2){acc[2], acc[3]} + bb2), s23)
            ap[0 * 64 + c2 * 16] = s01[0]; ap[1 * 64 + c2 * 16] = s01[1]; ap[2 * 64 + c2 * 16] = s23[0]; ap[3 * 64 + c2 * 16] = s23[1];
          }
          {
            f4 acc = (f4){0.f, 0.f, 0.f, 0.f};
            acc = __builtin_amdgcn_mfma_f32_16x16x32_f16(pa[0][0], bfr[0][c2][0], acc, 0, 0, 0);
            acc = __builtin_amdgcn_mfma_f32_16x16x32_f16(pa[0][1], bfr[0][c2][1], acc, 0, 0, 0);
            const f2 bb2 = (f2){bias[0][c2], bias[0][c2]};
            f2 s01, s23;
            SIG2(((f2){acc[0], acc[1]} + bb2), s01)
            SIG2(((f2){acc[2], acc[3]} + bb2), s23)
            const f2 a01 = s01 * (f2){-0.8750387749f, -0.8750387749f}, a23 = s23 * (f2){-0.8750387749f, -0.8750387749f};
            float wd[4], gam[4], gex[4];
            wd[0] = __builtin_amdgcn_exp2f(a01[0]); wd[1] = __builtin_amdgcn_exp2f(a01[1]); wd[2] = __builtin_amdgcn_exp2f(a23[0]); wd[3] = __builtin_amdgcn_exp2f(a23[1]);
            if (DIR == 0) { gex[0] = 1.f; gam[0] = wd[0]; gex[1] = gam[0]; gam[1] = gam[0] * wd[1]; gex[2] = gam[1]; gam[2] = gam[1] * wd[2]; gex[3] = gam[2]; gam[3] = gam[2] * wd[3]; }
            else { gex[3] = 1.f; gam[3] = wd[3]; gex[2] = gam[3]; gam[2] = gam[3] * wd[2]; gex[1] = gam[2]; gam[1] = gam[2] * wd[1]; gex[0] = gam[1]; gam[0] = gam[1] * wd[0]; }
            const float tot = DIR == 0 ? gam[3] : gam[0];
            const float t0_ = __shfl(tot, (lane & 15)), t1_ = __shfl(tot, (lane & 15) + 16), t2_ = __shfl(tot, (lane & 15) + 32), t3_ = __shfl(tot, (lane & 15) + 48);
            float E_;
            if (DIR == 0) E_ = (G_ > 0 ? t0_ : 1.f) * (G_ > 1 ? t1_ : 1.f) * (G_ > 2 ? t2_ : 1.f);
            else E_ = (G_ < 1 ? t1_ : 1.f) * (G_ < 2 ? t2_ : 1.f) * (G_ < 3 ? t3_ : 1.f);
            const f2 E2 = (f2){E_, E_};
            const f2 g01 = E2 * (f2){gam[0], gam[1]}, g23 = E2 * (f2){gam[2], gam[3]}, x01 = E2 * (f2){gex[0], gex[1]}, x23 = E2 * (f2){gex[2], gex[3]};
            lp[0 * 64 + c2 * 16] = g01[0]; lp[1 * 64 + c2 * 16] = g01[1]; lp[2 * 64 + c2 * 16] = g23[0]; lp[3 * 64 + c2 * 16] = g23[1];
            wp[0 * 64 + c2 * 16] = x01[0]; wp[1 * 64 + c2 * 16] = x01[1]; wp[2 * 64 + c2 * 16] = x23[0]; wp[3 * 64 + c2 * 16] = x23[1];
          }
        }
#undef SIG2
        if (i + 1 < NCHUNK) PREFETCH_PA(i + 1)
      }
      if (i >= 1 && i <= NCHUNK) {
        const int c = i - 1;
        const float* cb = Cb + ecg * 8;
        const float* ab = Ab + (c & 1) * 2048 + eq * 64 + ecg * 8;
        const float* lmb = Wb + (c & 1) * 2048 + eq * 64 + ecg * 8;
        const float* wlb = Wb + 4096 + (c & 1) * 2048 + eq * 64 + ecg * 8;
        const bool glast = DIR == 0 ? ((eq & 15) == 15) : ((eq & 15) == 0);
        float* o0 = Sb + (c & 1) * 10240 + eq * 64 + ecg * 8;
        const h8 hf8 = (h8){(_Float16)0.5f, (_Float16)0.5f, (_Float16)0.5f, (_Float16)0.5f, (_Float16)0.5f, (_Float16)0.5f, (_Float16)0.5f, (_Float16)0.5f};
        const h8 rs16 = pr[0][0] + *(const h8*)(Ch + ecg * 8) * ((pr[0][1] + pr[0][2]) * hf8 - pr[0][0]);
        const h8 ks16 = pr[1][0] + *(const h8*)(Ch + 64 + ecg * 8) * ((pr[1][1] + pr[1][2]) * hf8 - pr[1][0]);
        const h8 vs16 = pr[2][0] + *(const h8*)(Ch + 128 + ecg * 8) * ((pr[2][1] + pr[2][2]) * hf8 - pr[2][0]);
        float ksft[8], ssq = 0.f;
#pragma unroll
        for (int q = 0; q < 8; ++q) {
          ksft[q] = (float)ks16[q];
          const float kkr = ksft[q] * cb[192 + q];
          ssq += kkr * kkr;
        }
        ssq = red8(ssq);
        const float rn = rsqrtf(fmaxf(ssq, 1e-24f));
        float bo = 0.f;
#pragma unroll
        for (int hq = 0; hq < 2; ++hq) {
          f4 kk, bb, kd, rs, vs;
          const f4 a4 = *(const f4*)(ab + hq * 4);
          const f4 lm4 = *(const f4*)(lmb + hq * 4), wl4 = *(const f4*)(wlb + hq * 4);
          f4 gcur4;
#pragma unroll
          for (int qq = 0; qq < 4; ++qq) {
            const int q = hq * 4 + qq;
            rs[qq] = (float)rs16[q];
            vs[qq] = (float)vs16[q];
            const float kkv = ksft[q] * cb[192 + q] * rn;
            const float kdv = ksft[q] * (1.f + (a4[qq] - 1.f) * cb[256 + q]);
            bo += rs[qq] * kdv * cb[320 + q];
            const float gprev = wl4[qq], gcur = lm4[qq], ginv = __builtin_amdgcn_rcpf(gcur);
            kk[qq] = kkv * gprev; bb[qq] = kkv * a4[qq] * ginv; kd[qq] = kdv * ginv; rs[qq] *= gcur; gcur4[qq] = gcur;
          }
          *(f4*)(o0 + hq * 4) = kk;
          *(f4*)(o0 + 2048 + hq * 4) = bb;
          *(f4*)(o0 + 4096 + hq * 4) = kd;
          *(f4*)(o0 + 6144 + hq * 4) = rs;
          *(f4*)(o0 + 8192 + hq * 4) = vs;
          if (glast) *(f4*)(Gb + (c & 1) * 128 + (eq >> 4) * 64 + ecg * 8 + hq * 4) = gcur4;
        }
        bo = red8(bo);
        if (half == 0 && ecg == 0) p.BON[(unsigned)((e * NT + CD_TOK0(c) + TB_OF(c) + eq) * 8 + h)] = bo;
      }
      if (i < NCHUNK) PREFETCH_PR(i)
    } else {
      if (i >= 3) *(h4*)(yout + (size_t)(CD_TOK0(i - 3) + TB_OF(i - 3)) * 512) = *(const h4*)(Yb + ((i - 3) & 1) * 1024 + yq * 32 + yr4);
      if (i >= 2) {
        const int c = i - 2;
        if (CD_FIRST(c)) {
          if (CD_LAT(c)) {
            const float* sp = p.state + ((size_t)((CD_B(c) * 2 + e) * 8 + h)) * 4096 + irow * 64 + g * 8;
            f4 s0 = *(const f4*)(sp), s1 = *(const f4*)(sp + 4);
            S0 = (f2){s0[0], s0[1]}; S1 = (f2){s0[2], s0[3]}; S2 = (f2){s1[0], s1[1]}; S3 = (f2){s1[2], s1[3]};
          } else { S0 = (f2){0.f, 0.f}; S1 = S0; S2 = S0; S3 = S0; }
        }
        const float* Sc = Sb + (c & 1) * 10240;
        const float* Gc = Gb + (c & 1) * 128;
        _Float16* Yc = Yb + (c & 1) * 1024;
#pragma unroll 1
        for (int so = 0; so < 2; ++so) {
          const int qb = DIR == 0 ? so * 16 : 16 - so * 16;
          const float* Lb = Sc + qb * 64 + g * 8;
          const float* Lv = Sc + 8192 + qb * 64 + irow;
#define STEP_OFF(SI) ((DIR == 0 ? (SI) : 15 - (SI)) * 64)
          float cY = 0.f;
          f4 ka = *(const f4*)(Lb + STEP_OFF(0)), kb = *(const f4*)(Lb + 4 + STEP_OFF(0));
          f4 ba = *(const f4*)(Lb + 2048 + STEP_OFF(0)), bb_ = *(const f4*)(Lb + 2048 + 4 + STEP_OFF(0));
          f4 da = *(const f4*)(Lb + 4096 + STEP_OFF(0)), db = *(const f4*)(Lb + 4096 + 4 + STEP_OFF(0));
          f4 ra = *(const f4*)(Lb + 6144 + STEP_OFF(0)), rb_ = *(const f4*)(Lb + 6144 + 4 + STEP_OFF(0));
          float vv = Lv[STEP_OFF(0)];
#pragma unroll
          for (int si = 0; si < 16; ++si) {
            f4 nka, nkb, nba, nbb, nda, ndb, nra, nrb; float nvv;
            if (si < 15) {
              const int o = STEP_OFF(si + 1);
              nka = *(const f4*)(Lb + o); nkb = *(const f4*)(Lb + 4 + o);
              nba = *(const f4*)(Lb + 2048 + o); nbb = *(const f4*)(Lb + 2048 + 4 + o);
              nda = *(const f4*)(Lb + 4096 + o); ndb = *(const f4*)(Lb + 4096 + 4 + o);
              nra = *(const f4*)(Lb + 6144 + o); nrb = *(const f4*)(Lb + 6144 + 4 + o);
              nvv = Lv[o];
            }
            f2 dk = S0 * (f2){ka[0], ka[1]} + S1 * (f2){ka[2], ka[3]} + S2 * (f2){kb[0], kb[1]} + S3 * (f2){kb[2], kb[3]};
            const float sk = red8(dk[0] + dk[1]);
            const f2 nk2 = (f2){-sk, -sk}, v2_ = (f2){vv, vv};
            S0 = S0 + nk2 * (f2){ba[0], ba[1]} + v2_ * (f2){da[0], da[1]};
            S1 = S1 + nk2 * (f2){ba[2], ba[3]} + v2_ * (f2){da[2], da[3]};
            S2 = S2 + nk2 * (f2){bb_[0], bb_[1]} + v2_ * (f2){db[0], db[1]};
            S3 = S3 + nk2 * (f2){bb_[2], bb_[3]} + v2_ * (f2){db[2], db[3]};
            f2 dy = S0 * (f2){ra[0], ra[1]} + S1 * (f2){ra[2], ra[3]} + S2 * (f2){rb_[0], rb_[1]} + S3 * (f2){rb_[2], rb_[3]};
            const float yv = red8(dy[0] + dy[1]);
            cY = (g == (si & 7)) ? yv : cY;
            if ((si & 7) == 7) {
              const int st = so * 16 + (si - 7) + g;
              const int qq = DIR == 0 ? st : 31 - st;
              Yc[qq * 32 + rl] = (_Float16)(cY * 0.0625f);
            }
            if (si < 15) { ka = nka; kb = nkb; ba = nba; bb_ = nbb; da = nda; db = ndb; ra = nra; rb_ = nrb; vv = nvv; }
          }
#undef STEP_OFF
          { const f4 ga = *(const f4*)(Gc + (qb >> 4) * 64 + g * 8), gb = *(const f4*)(Gc + (qb >> 4) * 64 + g * 8 + 4);
            S0 = S0 * (f2){ga[0], ga[1]}; S1 = S1 * (f2){ga[2], ga[3]}; S2 = S2 * (f2){gb[0], gb[1]}; S3 = S3 * (f2){gb[2], gb[3]}; }
        }
        if (CD_LAST(c) && !CD_LAT(c)) {
          float* op = p.out + (size_t)NT * DM + ((size_t)((CD_B(c) * 2 + e) * 8 + h)) * 4096 + irow * 64 + g * 8;
          *(f4*)(op) = (f4){S0[0], S0[1], S1[0], S1[1]};
          *(f4*)(op + 4) = (f4){S2[0], S2[1], S3[0], S3[1]};
        }
      }
    }
    __syncthreads();
  }
  if (w < 4) *(h4*)(yout + (size_t)(CD_TOK0(NCHUNK - 1) + TB_OF(NCHUNK - 1)) * 512) = *(const h4*)(Yb + ((NCHUNK - 1) & 1) * 1024 + yq * 32 + yr4);
#undef TB_OF
#undef PREFETCH_PA
#undef PREFETCH_PR
#undef CD_LAT
#undef CD_C
#undef CD_B
#undef CD_T
#undef CD_RLM
#undef CD_TOK0
#undef CD_FIRST
#undef CD_LAST
  __syncthreads();
}

__device__ __forceinline__ bool scan_get_item(int it, bool& is_lat, int& chain, int& half) {
  const int G = gridDim.x, bid = blockIdx.x;
  int i;
  if (G >= 512) {
    if (bid < 256) { if (it > 0) return false; i = bid; }
    else { const int j = bid - 256 + it * (G - 256); if (j >= 1024) return false; i = 256 + j; }
  } else { i = bid + it * G; if (i >= 1280) return false; }
  if (i < 256) { is_lat = true; chain = (i >> 4) * 8 + (i & 7); half = (i >> 3) & 1; }
  else { const int j = i - 256, bp = j & 255, rnd = j >> 8; is_lat = false; chain = rnd * 128 + (bp >> 4) * 8 + (bp & 7); half = (bp >> 3) & 1; }
  return true;
}
__device__ __forceinline__ void scan_phase(const Params& p, unsigned char* smem) {
  if (gridDim.x == 256) {
    const int bid = blockIdx.x, cbase = (bid >> 4) * 8 + (bid & 7), h_ = cbase & 7, e_ = (cbase >> 3) & 1, half_ = (bid >> 3) & 1;
    if (e_ == 0) scan_stream2<0>(p, cbase, h_, half_, smem); else scan_stream2<1>(p, cbase, h_, half_, smem);
    return;
  }
  for (int it = 0;; ++it) {
    bool is_lat; int chain, half;
    if (!scan_get_item(it, is_lat, chain, half)) break;
    const int h = chain & 7, e = (chain >> 3) & 1, b = chain >> 4;
    if (e == 0) scan_item<0>(p, is_lat, b, h, half, smem); else scan_item<1>(p, is_lat, b, h, half, smem);
  }
}

__device__ __forceinline__ void ld8nt(const _Float16* ptr, float (&o)[8]) {
  h8 v = __builtin_nontemporal_load((const h8*)ptr);
#pragma unroll
  for (int q = 0; q < 8; ++q) o[q] = (float)v[q];
}
__device__ __forceinline__ void ld8(const _Float16* ptr, bool valid, float (&o)[8]) {
  h8 v = valid ? *(const h8*)ptr : (h8){0, 0, 0, 0, 0, 0, 0, 0};
#pragma unroll
  for (int q = 0; q < 8; ++q) o[q] = (float)v[q];
}
__device__ __forceinline__ void phase4(const Params& p) {
  int tid = threadIdx.x; asm volatile("" : "+v"(tid));
  const int lane = tid & 63, w = tid >> 6;
  const int c0 = lane * 8;
  f4 kmu[2], kgw[2], kgb[2], kw0[2], kw1[2], kw2[2];
#pragma unroll
  for (int hq = 0; hq < 2; ++hq) {
    kmu[hq] = *(const f4*)(p.shift_mu + 1024 + c0 + hq * 4); kgw[hq] = *(const f4*)(p.gn_w + c0 + hq * 4); kgb[hq] = *(const f4*)(p.gn_b + c0 + hq * 4);
    kw0[hq] = *(const f4*)(p.conv_w + c0 + hq * 4); kw1[hq] = *(const f4*)(p.conv_w + 512 + c0 + hq * 4); kw2[hq] = *(const f4*)(p.conv_w + 1024 + c0 + hq * 4);
  }
  for (int tok = blockIdx.x * 8 + w; tok < NT; tok += gridDim.x * 8) {
    const bool is_lat = tok >= NCTX;
    const int t = is_lat ? ((tok - NCTX) & 4095) : (tok & 255);
    const int RLm = is_lat ? 63 : 255;
    const bool pv = (t & RLm) != 0, nv = (t & RLm) != RLm;
    float y0[8], y1[8], ys[8];
    ld8nt(p.HY + (size_t)tok * 512 + c0, y0);
    ld8nt(p.HY + ((size_t)NT + tok) * 512 + c0, y1);
    float sum = 0.f;
#pragma unroll
    for (int q = 0; q < 8; ++q) { ys[q] = (y0[q] + y1[q]) * 16.f; sum += ys[q]; }
    sum = red8(sum);
    const float mean = sum * (1.f / 64.f);
    float sq = 0.f;
#pragma unroll
    for (int q = 0; q < 8; ++q) { float dlt = ys[q] - mean; sq += dlt * dlt; }
    sq = red8(sq);
    const float rstd = rsqrtf(sq * (1.f / 64.f) + 64e-5f);
    const int hA = lane >> 3;
    const float bon = p.BON[(size_t)tok * 8 + hA] + p.BON[((size_t)NT + tok) * 8 + hA];
    float vc[8], vp[8], vn[8], ga[8];
    const _Float16* p1 = p.P1 + (size_t)tok * LD1 + 1024 + c0;
    ld8(p1, true, vc); ld8(p1 - LD1, pv, vp); ld8(p1 + LD1, nv, vn);
    _Float16* p2 = p.P2 + (size_t)tok * LD2;
    ld8nt(p2 + c0, ga);
    h8 za;
#pragma unroll
    for (int q = 0; q < 8; ++q) {
      const int ch = c0 + q;
      float vsft = vc[q] + kmu[q >> 2][q & 3] * (0.5f * (vp[q] + vn[q]) - vc[q]);
      float gn = (ys[q] - mean) * rstd * kgw[q >> 2][q & 3] + kgb[q >> 2][q & 3];
      za[q] = (_Float16)((gn + bon * vsft) * siluf_(ga[q]));
    }
    *(h8*)(p2 + c0) = za;
    float bsg[8], cuc[8], cup[8], cun[8];
    ld8nt(p2 + 512 + c0, bsg); ld8(p2 + 1024 + c0, true, cuc);
    int dp; bool pvb, nvb;
    if (is_lat && lane >= 32) { dp = 64; pvb = t >= 64; nvb = t < 4096 - 64; } else { dp = 1; pvb = pv; nvb = nv; }
    ld8(p2 - (size_t)dp * LD2 + 1024 + c0, pvb, cup);
    ld8(p2 + (size_t)dp * LD2 + 1024 + c0, nvb, cun);
    h8 zb;
#pragma unroll
    for (int q = 0; q < 8; ++q) {
      const int ch = c0 + q;
      float conv = kw0[q >> 2][q & 3] * cup[q] + kw1[q >> 2][q & 3] * cuc[q] + kw2[q >> 2][q & 3] * cun[q];
      zb[q] = (_Float16)(bsg[q] * conv);
    }
    *(h8*)(p2 + 512 + c0) = zb;
  }
}

__device__ __forceinline__ void phase6(const Params& p) {
  int tid = threadIdx.x; asm volatile("" : "+v"(tid));
  const int lane = tid & 63, w = tid >> 6;
  f4 fg[2][2];
#pragma unroll
  for (int i = 0; i < 2; ++i) { fg[i][0] = *(const f4*)(p.final_g + i * 512 + lane * 8); fg[i][1] = *(const f4*)(p.final_g + i * 512 + lane * 8 + 4); }
  for (int tok0 = blockIdx.x * 8 + w; tok0 < NT / 2; tok0 += gridDim.x * 8) {
    h8 v[2][2]; float ss[2];
#pragma unroll
    for (int u = 0; u < 2; ++u) {
      const _Float16* zr = p.HY + (size_t)(tok0 + u * (NT / 2)) * DM;
      v[u][0] = __builtin_nontemporal_load((const h8*)(zr + lane * 8)); v[u][1] = __builtin_nontemporal_load((const h8*)(zr + 512 + lane * 8));
    }
#pragma unroll
    for (int u = 0; u < 2; ++u) {
      float t = 0.f;
#pragma unroll
      for (int i = 0; i < 2; ++i)
#pragma unroll
        for (int q = 0; q < 8; ++q) { const float x = (float)v[u][i][q]; t += x * x; }
      ss[u] = red64(t);
    }
#pragma unroll
    for (int u = 0; u < 2; ++u) {
      float* orow = p.out + (size_t)(tok0 + u * (NT / 2)) * DM;
      const float rstd = rsqrtf(ss[u] * (1.f / 1024.f) + 1e-6f);
#pragma unroll
      for (int i = 0; i < 2; ++i) {
        const int col = i * 512 + lane * 8;
        const f4 g0 = fg[i][0], g1 = fg[i][1];
        f4 o0, o1;
#pragma unroll
        for (int q = 0; q < 4; ++q) { o0[q] = (float)v[u][i][q] * rstd * g0[q]; o1[q] = (float)v[u][i][4 + q] * rstd * g1[q]; }
        __builtin_nontemporal_store(o0, (f4*)(orow + col)); __builtin_nontemporal_store(o1, (f4*)(orow + col + 4));
      }
    }
  }
}

__device__ __forceinline__ void grid_barrier(unsigned* bar, unsigned target) {
  asm volatile("s_waitcnt vmcnt(0)" ::: "memory");
  __syncthreads();
  if (threadIdx.x == 0) {
    __builtin_amdgcn_fence(__ATOMIC_RELEASE, "agent");
    asm volatile("s_waitcnt vmcnt(0)" ::: "memory");
    __hip_atomic_fetch_add(bar, 1u, __ATOMIC_RELAXED, __HIP_MEMORY_SCOPE_AGENT);
    while (__hip_atomic_load(bar, __ATOMIC_RELAXED, __HIP_MEMORY_SCOPE_AGENT) < target) __builtin_amdgcn_s_sleep(1);
    __builtin_amdgcn_fence(__ATOMIC_ACQUIRE, "agent");
    asm volatile("s_waitcnt vmcnt(0)" ::: "memory");
  }
  __syncthreads();
}

__global__ void __launch_bounds__(NTHREADS, 2) mega_kernel(Params p) {
  __shared__ __attribute__((aligned(16))) unsigned char smem[SMEM_BYTES];
  cg::grid_group grid = cg::this_grid();
#ifndef PH_MASK
#define PH_MASK 0x7F
#endif
  unsigned nbar = 0;
  if (PH_MASK & 1) phase0(p, smem);
  if (blockIdx.x < 48) {
    asm volatile("s_waitcnt vmcnt(0)" ::: "memory");
    __syncthreads();
    if (threadIdx.x == 0) { __builtin_amdgcn_fence(__ATOMIC_RELEASE, "agent"); asm volatile("s_waitcnt vmcnt(0)" ::: "memory"); __hip_atomic_fetch_add(p.bar + 32, 1u, __ATOMIC_RELAXED, __HIP_MEMORY_SCOPE_AGENT); }
  }
  if (p.bar == nullptr) grid.sync();
  if (PH_MASK & 2) {
    phase_weights(p, smem);
    if (threadIdx.x == 0) {
      const unsigned need = gridDim.x < 48u ? gridDim.x : 48u;
      while (__hip_atomic_load(p.bar + 32, __ATOMIC_RELAXED, __HIP_MEMORY_SCOPE_AGENT) < need) __builtin_amdgcn_s_sleep(1);
      __builtin_amdgcn_fence(__ATOMIC_ACQUIRE, "agent");
      asm volatile("s_waitcnt vmcnt(0)" ::: "memory");
    }
    __syncthreads();
    phase1(p);
  }
  grid_barrier(p.bar, ++nbar * gridDim.x);
#ifdef DUP_SMALL
  phase0(p, smem);
  grid_barrier(p.bar, ++nbar * gridDim.x);
  phase1(p);
  grid_barrier(p.bar, ++nbar * gridDim.x);
#endif
  if (PH_MASK & 4) { pg8::Gemm g_{(const pg8::bf16_t*)p.HY, (const pg8::bf16_t*)p.WCAT, NT, NCAT, DM, DM}; pg8::StaticOrder S_; S_.init(NT, NCAT, gridDim.x, blockIdx.x); EpiProj E_{p.P1, p.P2}; pg8::gemm_phase((PG8_LAS unsigned char*)smem, g_, S_, E_); }
  grid_barrier(p.bar, ++nbar * gridDim.x);
#ifdef DUP_G1
  { pg8::Gemm g_{(const pg8::bf16_t*)p.HY, (const pg8::bf16_t*)p.WCAT, NT, NCAT, DM, DM}; pg8::StaticOrder S_; S_.init(NT, NCAT, gridDim.x, blockIdx.x); EpiProj E_{p.P1, p.P2}; pg8::gemm_phase((PG8_LAS unsigned char*)smem, g_, S_, E_); }
  grid_barrier(p.bar, ++nbar * gridDim.x);
#endif
  if (PH_MASK & 8) scan_phase(p, smem);
  grid_barrier(p.bar, ++nbar * gridDim.x);
#ifdef DUP_SCAN
  scan_phase(p, smem);
  grid_barrier(p.bar, ++nbar * gridDim.x);
#endif
  if (PH_MASK & 16) phase4(p);
  grid_barrier(p.bar, ++nbar * gridDim.x);
  if (PH_MASK & 32) { pg8::Gemm g_{(const pg8::bf16_t*)p.P2, (const pg8::bf16_t*)p.WOUT, NT, DM, DM, LD2}; pg8::StaticOrder S_; S_.init(NT, DM, gridDim.x, blockIdx.x); EpiOut E_{p.x_prompt, p.x_sample, p.MOD, p.HY}; pg8::gemm_phase((PG8_LAS unsigned char*)smem, g_, S_, E_); }
  grid_barrier(p.bar, ++nbar * gridDim.x);
#ifdef DUP_SMALL
  { pg8::Gemm g_{(const pg8::bf16_t*)p.P2, (const pg8::bf16_t*)p.WOUT, NT, DM, DM, LD2}; pg8::StaticOrder S_; S_.init(NT, DM, gridDim.x, blockIdx.x); EpiOut E_{p.x_prompt, p.x_sample, p.MOD, p.HY}; pg8::gemm_phase((PG8_LAS unsigned char*)smem, g_, S_, E_); }
  grid_barrier(p.bar, ++nbar * gridDim.x);
#endif
  if (PH_MASK & 64) phase6(p);
}

extern "C" void kernel_launch(void* const* d_in, const int* in_sizes, int n_in, void* d_out, int out_size, void* d_ws,
                              size_t ws_size, hipStream_t stream) {
  static int grid_blocks = 0;
  if (!grid_blocks) {
    int dev = 0, cus = 0, per_cu = 0;
    hipGetDevice(&dev);
    hipDeviceGetAttribute(&cus, hipDeviceAttributeMultiprocessorCount, dev);
    hipOccupancyMaxActiveBlocksPerMultiprocessor(&per_cu, mega_kernel, NTHREADS, 0);
    if (per_cu > 1) per_cu = 1;
    if (per_cu < 1) per_cu = 1;
    grid_blocks = cus * per_cu;
  }
  Params p{};
  const float* const* in = (const float* const*)d_in;
  p.x_prompt = in[0]; p.x_sample = in[1]; p.c = in[2]; p.state = in[3]; p.c_ctx = in[4]; p.w_ada = in[5]; p.b_ada = in[6];
  p.norm_g = in[7]; p.w_in = in[8]; p.shift_mu = in[9]; p.decay_w0 = in[10]; p.decay_down = in[11]; p.decay_up = in[12];
  p.iclr_bias = in[13]; p.iclr_down = in[14]; p.iclr_up = in[15]; p.kk_scale = in[16]; p.ka_scale = in[17];
  p.bonus_rk = in[18]; p.gn_w = in[19]; p.gn_b = in[20]; p.conv_w = in[21]; p.w_out = in[22]; p.final_g = in[23];
  p.out = (float*)d_out;
  unsigned char* ws = (unsigned char*)d_ws;
  size_t off = 0;
  p.MOD = (float*)(ws + off); p.bar = (unsigned*)(ws + off + 122880); off += 131072;
  p.WCAT = (_Float16*)(ws + off); off += (size_t)NCAT * 1024 * 2;
  p.WOUT = (_Float16*)(ws + off); off += (size_t)1024 * 1024 * 2;
  p.UPT = (_Float16*)(ws + off); off += (size_t)4 * 512 * 64 * 2;
  p.BON = (float*)(ws + off); off += (size_t)2 * NT * 8 * 4;
  p.HY = (_Float16*)(ws + off); off += (size_t)NT * 1024 * 2;
  p.P1 = (_Float16*)(ws + off); off += (size_t)NT * LD1 * 2;
  p.P2 = (_Float16*)(ws + off); off += (size_t)NT * LD2 * 2;
  if (off > ws_size) { fprintf(stderr, "workspace too small: need %zu have %zu\n", off, ws_size); return; }
  hipMemsetAsync(p.bar, 0, 256, stream);
  void* args[] = {&p};
  hipError_t err = hipLaunchCooperativeKernel((void*)mega_kernel, dim3(grid_blocks), dim3(NTHREADS), args, 0, stream);
  if (err != hipSuccess) fprintf(stderr, "cooperative launch failed: %s (grid %d)\n", hipGetErrorString(err), grid_blocks);
}
```

```cpp
#include <hip/hip_runtime.h>
#include <hip/hip_cooperative_groups.h>
#include <cstdio>
namespace cg = cooperative_groups;

typedef _Float16 h8 __attribute__((ext_vector_type(8)));
typedef _Float16 h4 __attribute__((ext_vector_type(4)));
typedef _Float16 h2 __attribute__((ext_vector_type(2)));
typedef float f2 __attribute__((ext_vector_type(2)));
typedef float f4 __attribute__((ext_vector_type(4)));
typedef float f16v __attribute__((ext_vector_type(16)));

#define NTHREADS 512
constexpr int NT = 40960;
constexpr int NCTX = 8192;
constexpr int DM = 1024;
constexpr int NCAT = 4352;
constexpr int LD1 = 1792;
constexpr int LD2 = 1536;
constexpr int SMEM_BYTES = 139264;

struct Params {
  const float *x_prompt, *x_sample, *c, *state, *c_ctx, *w_ada, *b_ada, *norm_g, *w_in, *shift_mu, *decay_w0,
      *decay_down, *decay_up, *iclr_bias, *iclr_down, *iclr_up, *kk_scale, *ka_scale, *bonus_rk, *gn_w, *gn_b,
      *conv_w, *w_out, *final_g;
  float* out;
  float* MOD;
  _Float16* WCAT;
  _Float16* WOUT;
  _Float16* UPT;
  float* BON;
  _Float16* HY;
  _Float16* P1;
  _Float16* P2;
  unsigned* bar;
};

__device__ __forceinline__ float sigmoidf_(float x) { return __builtin_amdgcn_rcpf(1.f + __expf(-x)); }
__device__ __forceinline__ float siluf_(float x) { return x * sigmoidf_(x); }

template <int CTRL> __device__ __forceinline__ float dpp_add(float x) {
  int y = __builtin_amdgcn_update_dpp(0, __builtin_bit_cast(int, x), CTRL, 0xf, 0xf, true);
  float r = x + __builtin_bit_cast(float, y);
  asm("" : "+v"(r));
  return r;
}
__device__ __forceinline__ float red16(float x) {
  x = dpp_add<0xB1>(x); x = dpp_add<0x4E>(x); x = dpp_add<0x141>(x); x = dpp_add<0x140>(x); return x;
}
__device__ __forceinline__ float red8(float x) {
  x = dpp_add<0xB1>(x); x = dpp_add<0x4E>(x); x = dpp_add<0x141>(x); return x;
}
__device__ __forceinline__ float red64(float x) {
  x = red16(x);
  x += __shfl_xor(x, 16); x += __shfl_xor(x, 32); return x;
}

__device__ __forceinline__ void transpose_tile(const float* __restrict__ src, int ld_src, int k0, int sn0,
                                               _Float16* __restrict__ dst, int ld_dst, int dn0, float* tile, int sn0b = -1) {
  const int tid = threadIdx.x;
#pragma unroll
  for (int rep = 0; rep < 2; ++rep) {
    int idx = tid + rep * NTHREADS; int i = idx >> 4; int j4 = (idx & 15) * 4;
    const int scol = (sn0b >= 0 && j4 >= 32) ? sn0b + (j4 - 32) : sn0 + j4;
    f4 v = __builtin_nontemporal_load((const f4*)(src + (size_t)(k0 + i) * ld_src + scol));
    tile[i * 65 + j4 + 0] = v[0]; tile[i * 65 + j4 + 1] = v[1]; tile[i * 65 + j4 + 2] = v[2]; tile[i * 65 + j4 + 3] = v[3];
  }
  __syncthreads();
  int j = tid >> 3, i8 = (tid & 7) * 8;
  h8 o;
#pragma unroll
  for (int q = 0; q < 8; ++q) o[q] = (_Float16)tile[(i8 + q) * 65 + j];
  const int drow = sn0b >= 0 ? dn0 + 2 * (j & 31) + (j >> 5) : dn0 + j;
  *(h8*)(dst + (size_t)drow * ld_dst + k0 + i8) = o;
  __syncthreads();
}

__device__ __forceinline__ void phase0(const Params& p, unsigned char* smem) {
  int tid = threadIdx.x; asm volatile("" : "+v"(tid));
  const int lane = tid & 63, w = tid >> 6;
  float* fs = (float*)smem;
  for (int item = blockIdx.x; item < 48; item += gridDim.x) {
    float* sc = fs;
    float* red = fs + 9 * 1024;
    for (int idx = tid; idx < 9 * 1024; idx += NTHREADS) {
      int r = idx >> 10, k = idx & 1023;
      float cv = (r == 0) ? p.c_ctx[k] : p.c[(r - 1) * 1024 + k];
      sc[idx] = siluf_(cv);
    }
    __syncthreads();
    const int j0 = item * 64, cq = lane & 15, ks = lane >> 4;
    f4 acc[9];
#pragma unroll
    for (int r = 0; r < 9; ++r) acc[r] = (f4){0.f, 0.f, 0.f, 0.f};
#pragma unroll
    for (int i = 0; i < 32; ++i) {
      int k = w * 128 + i * 4 + ks;
      f4 wv = __builtin_nontemporal_load((const f4*)(p.w_ada + (size_t)k * 3072 + j0 + cq * 4));
#pragma unroll
      for (int r = 0; r < 9; ++r) { float s = sc[r * 1024 + k]; acc[r] += wv * s; }
    }
#pragma unroll
    for (int r = 0; r < 9; ++r)
#pragma unroll
      for (int q = 0; q < 4; ++q) { float v = acc[r][q]; v += __shfl_xor(v, 16); v += __shfl_xor(v, 32); acc[r][q] = v; }
    if (ks == 0) {
#pragma unroll
      for (int r = 0; r < 9; ++r) *(f4*)(red + (w * 9 + r) * 64 + cq * 4) = acc[r];
    }
    __syncthreads();
    for (int idx = tid; idx < 9 * 64; idx += NTHREADS) {
      int r = idx >> 6, cidx = idx & 63;
      float s = p.b_ada[j0 + cidx];
#pragma unroll
      for (int ww = 0; ww < 8; ++ww) s += red[(ww * 9 + r) * 64 + cidx];
      p.MOD[r * 3072 + j0 + cidx] = s;
    }
    __syncthreads();
  }
}

__device__ __forceinline__ void phase_weights(const Params& p, unsigned char* smem) {
  float* fs = (float*)smem;
  for (int t = blockIdx.x; t < 1376; t += gridDim.x) {
    if (t < 1088) {
      int nt = t >> 4, kt = t & 15, n0 = nt * 64;
      if (n0 < 2048) transpose_tile(p.w_in, 4096, kt * 64, n0, p.WCAT, 1024, n0, fs);
      else if (n0 < 3072) transpose_tile(p.w_in, 4096, kt * 64, 2560 + ((n0 - 2048) >> 1), p.WCAT, 1024, n0, fs, 3072 + ((n0 - 2048) >> 1));
      else if (n0 < 4096) transpose_tile(p.w_in, 4096, kt * 64, 2048 + ((n0 - 3072) >> 1), p.WCAT, 1024, n0, fs, 3584 + ((n0 - 3072) >> 1));
      else if (n0 < 4224) transpose_tile(p.decay_down + (size_t)((n0 - 4096) >> 6) * 65536, 64, kt * 64, 0, p.WCAT, 1024, n0, fs);
      else transpose_tile(p.iclr_down + (size_t)((n0 - 4224) >> 6) * 65536, 64, kt * 64, 0, p.WCAT, 1024, n0, fs);
    } else if (t < 1344) {
      int tt = t - 1088, nt = tt >> 4, kt = tt & 15;
      transpose_tile(p.w_out, 1024, kt * 64, nt * 64, p.WOUT, 1024, nt * 64, fs);
    } else {
      int tt = t - 1344, q = tt >> 3, ct = tt & 7, e = q >> 1, which = q & 1;
      const float* src = (which ? p.iclr_up : p.decay_up) + (size_t)e * 64 * 512;
      transpose_tile(src, 512, 0, ct * 64, p.UPT + (size_t)q * 512 * 64, 64, ct * 64, fs);
    }
  }
}

__device__ __forceinline__ void phase1(const Params& p) {
  int tid = threadIdx.x; asm volatile("" : "+v"(tid));
  const int lane = tid & 63, w = tid >> 6;
  for (int tok0 = blockIdx.x * 8 + w; tok0 < NT / 2; tok0 += gridDim.x * 8) {
    f4 v[2][4]; float ss[2];
#pragma unroll
    for (int u = 0; u < 2; ++u) {
      const int tok = tok0 + u * (NT / 2);
      const float* xr = tok < NCTX ? p.x_prompt + (size_t)tok * DM : p.x_sample + (size_t)(tok - NCTX) * DM;
#pragma unroll
      for (int i = 0; i < 4; ++i) v[u][i] = __builtin_nontemporal_load((const f4*)(xr + i * 256 + lane * 4));
    }
#pragma unroll
    for (int u = 0; u < 2; ++u) {
      float t = 0.f;
#pragma unroll
      for (int i = 0; i < 4; ++i) t += v[u][i][0] * v[u][i][0] + v[u][i][1] * v[u][i][1] + v[u][i][2] * v[u][i][2] + v[u][i][3] * v[u][i][3];
      ss[u] = red64(t);
    }
#pragma unroll
    for (int u = 0; u < 2; ++u) {
      const int tok = tok0 + u * (NT / 2);
      const int mb = tok < NCTX ? 0 : 1 + ((tok - NCTX) >> 12);
      const float rstd = rsqrtf(ss[u] * (1.f / 1024.f) + 1e-6f);
#pragma unroll
      for (int i = 0; i < 4; ++i) {
        int col = i * 256 + lane * 4;
        f4 g = *(const f4*)(p.norm_g + col);
        f4 sh = *(const f4*)(p.MOD + mb * 3072 + col);
        f4 sc = *(const f4*)(p.MOD + mb * 3072 + 1024 + col);
        h4 o;
#pragma unroll
        for (int q = 0; q < 4; ++q) o[q] = (_Float16)((v[u][i][q] * rstd * g[q]) * (1.f + sc[q]) + sh[q]);
        *(h4*)(p.HY + (size_t)tok * DM + col) = o;
      }
    }
  }
}

template <int EPI>
__device__ __forceinline__ void gemm_phase(const Params& p, const _Float16* __restrict__ A, int lda, const _Float16* __restrict__ Bt,
                           int K, int nMt, int nNt, unsigned char* smem) {
  int tid = threadIdx.x; asm volatile("" : "+v"(tid));
  const int lane = tid & 63, w = tid >> 6, wm = w >> 2, wn = w & 3;
  _Float16* As = (_Float16*)smem;
  _Float16* Bs = As + 2 * 256 * 40;
  const int lrow = tid >> 2, lseg = tid & 3;
  const int G = gridDim.x;
  const bool xcdmap = ((G & 7) == 0) && ((nMt & 31) == 0);
  const int nunits = xcdmap ? (nMt >> 3) * nNt : nMt * nNt;
  const int ustart = xcdmap ? (blockIdx.x >> 3) : blockIdx.x;
  const int ustep = xcdmap ? (G >> 3) : G;
  const int nk = K >> 5;
  const int nmi = nMt >> 3, nfull = nNt >> 3, nrem = nNt & 7, gunits = nmi * 8;
#define UNIT_DECODE(U, MT, NT)                                                                                     \
  if (xcdmap) {                        \
    int mi;                                                                                                       \
    if ((U) < nfull * gunits) { const int g_ = (U) / gunits, r_ = (U) - g_ * gunits, w32 = r_ & 31; mi = (r_ >> 5) * 4 + (w32 >> 3); NT = g_ * 8 + (w32 & 7); } \
    else { const int r_ = (U) - nfull * gunits; mi = r_ / nrem; NT = nfull * 8 + (r_ - mi * nrem); }               \
    MT = (blockIdx.x & 7) + 8 * mi;                                                                               \
  } else { MT = (U) / nNt; NT = (U) % nNt; }
  const size_t astep = (size_t)128 * lda, bstep = (size_t)128 * K;
  h8 ra[4][2], rb[4][2];
#define GEMM_LOAD(S, KT)                                                                           \
    { ra[S][0] = *(const h8*)(ag + (KT) * 32); ra[S][1] = *(const h8*)(ag + astep + (KT) * 32);     \
      rb[S][0] = *(const h8*)(bg + (KT) * 32); rb[S][1] = *(const h8*)(bg + bstep + (KT) * 32); }
  bool preloaded = false;
  for (int u = ustart; u < nunits; u += ustep) {
    int mt_, nt_;
    UNIT_DECODE(u, mt_, nt_)
    const int m0 = mt_ * 256, n0 = nt_ * 256;
    const _Float16* ag = A + (size_t)(m0 + lrow) * lda + lseg * 8;
    const _Float16* bg = Bt + (size_t)(n0 + lrow) * K + lseg * 8;
    f16v acc[4][2];
#pragma unroll
    for (int a = 0; a < 4; ++a)
#pragma unroll
      for (int b = 0; b < 2; ++b)
#pragma unroll
        for (int r = 0; r < 16; ++r) acc[a][b][r] = 0.f;
#define GEMM_STORE(S, BUF)                                                                         \
    { *(h8*)(As + (BUF) * 256 * 40 + lrow * 40 + lseg * 8) = ra[S][0]; *(h8*)(As + (BUF) * 256 * 40 + (lrow + 128) * 40 + lseg * 8) = ra[S][1]; \
      *(h8*)(Bs + (BUF) * 256 * 40 + lrow * 40 + lseg * 8) = rb[S][0]; *(h8*)(Bs + (BUF) * 256 * 40 + (lrow + 128) * 40 + lseg * 8) = rb[S][1]; }
    if (!preloaded) { GEMM_LOAD(0, 0) GEMM_LOAD(1, 1) GEMM_LOAD(2, 2) GEMM_LOAD(3, 3) }
    GEMM_STORE(0, 0)
    __syncthreads();
    const _Float16* Ac = As + (wm * 128 + (lane & 31)) * 40 + (lane >> 5) * 8;
    const _Float16* Bc = Bs + (wn * 64 + (lane & 31)) * 40 + (lane >> 5) * 8;
#define GEMM_COMPUTE(CUR)                                                                                         \
    _Pragma("unroll") for (int ks = 0; ks < 2; ++ks) {                                                            \
      h8 af[4], bf[2];                                                                                            \
      _Pragma("unroll") for (int a = 0; a < 4; ++a) af[a] = *(const h8*)(Ac + (CUR) * 256 * 40 + a * 32 * 40 + ks * 16); \
      _Pragma("unroll") for (int b = 0; b < 2; ++b) bf[b] = *(const h8*)(Bc + (CUR) * 256 * 40 + b * 32 * 40 + ks * 16); \
      _Pragma("unroll") for (int a = 0; a < 4; ++a)                                                               \
        _Pragma("unroll") for (int b = 0; b < 2; ++b)                                                             \
          acc[a][b] = __builtin_amdgcn_mfma_f32_32x32x16_f16(bf[b], af[a], acc[a][b], 0, 0, 0);                   \
    }
    for (int kt = 0; kt < nk; kt += 4) {
#pragma unroll
      for (int s_ = 0; s_ < 4; ++s_) {
        if (kt + s_ + 4 < nk) GEMM_LOAD(s_, kt + s_ + 4)
        GEMM_COMPUTE(s_ & 1)
        if (kt + s_ + 1 < nk) GEMM_STORE((s_ + 1) & 3, (s_ + 1) & 1)
        __syncthreads();
      }
    }
#undef GEMM_COMPUTE
#undef GEMM_STORE
    preloaded = false;
    if (u + ustep < nunits) {
      int mtn, ntn;
      UNIT_DECODE(u + ustep, mtn, ntn)
      const _Float16* agn = A + (size_t)(mtn * 256 + lrow) * lda + lseg * 8;
      const _Float16* bgn = Bt + (size_t)(ntn * 256 + lrow) * K + lseg * 8;
#pragma unroll
      for (int s_ = 0; s_ < 4; ++s_) {
        ra[s_][0] = *(const h8*)(agn + s_ * 32); ra[s_][1] = *(const h8*)(agn + astep + s_ * 32);
        rb[s_][0] = *(const h8*)(bgn + s_ * 32); rb[s_][1] = *(const h8*)(bgn + bstep + s_ * 32);
      }
      preloaded = true;
    }
    if (EPI == 1) {
      _Float16* dst; int ldd, dcol; bool dotanh = false;
      if (nt_ < 6) { dst = p.P1; ldd = LD1; dcol = n0; }
      else if (nt_ < 16) { dst = p.P2; ldd = LD2; dcol = n0 - 1536; }
      else { dst = p.P1; ldd = LD1; dcol = 1536 + (n0 - 4096); dotanh = (wn < 2); }
      _Float16* Cs = (_Float16*)smem + w * (32 * 72);
#pragma unroll
      for (int a = 0; a < 4; ++a) {
#pragma unroll
        for (int b = 0; b < 2; ++b)
#pragma unroll
          for (int rb4 = 0; rb4 < 4; ++rb4) {
            h4 o;
#pragma unroll
            for (int q = 0; q < 4; ++q) {
              float v = acc[a][b][rb4 * 4 + q];
              if (dotanh) v = 1.f - 2.f * __builtin_amdgcn_rcpf(__expf(2.f * v) + 1.f);
              o[q] = (_Float16)v;
            }
            *(h4*)(Cs + (lane & 31) * 72 + b * 32 + rb4 * 8 + (lane >> 5) * 4) = o;
          }
        __syncthreads();
#pragma unroll
        for (int it = 0; it < 4; ++it) {
          int chunk = it * 64 + lane, row = chunk >> 3, c16 = chunk & 7;
          h8 v = *(const h8*)(Cs + row * 72 + c16 * 8);
          *(h8*)(dst + (size_t)(m0 + wm * 128 + a * 32 + row) * ldd + dcol + wn * 64 + c16 * 8) = v;
        }
        __syncthreads();
      }
    } else {
#pragma unroll
      for (int a = 0; a < 4; ++a) {
        const int tok = m0 + wm * 128 + a * 32 + (lane & 31);
        const float* xr = tok < NCTX ? p.x_prompt + (size_t)tok * DM : p.x_sample + (size_t)(tok - NCTX) * DM;
        const int mb = tok < NCTX ? 0 : 1 + ((tok - NCTX) >> 12);
#pragma unroll
        for (int b = 0; b < 2; ++b)
#pragma unroll
          for (int rb4 = 0; rb4 < 4; ++rb4) {
            int col = n0 + wn * 64 + b * 32 + rb4 * 8 + (lane >> 5) * 4;
            f4 xv = *(const f4*)(xr + col);
            f4 gv = *(const f4*)(p.MOD + mb * 3072 + 2048 + col);
            f4 o;
#pragma unroll
            for (int q = 0; q < 4; ++q) o[q] = xv[q] + gv[q] * acc[a][b][rb4 * 4 + q];
            *(f4*)(p.out + (size_t)tok * DM + col) = o;
          }
      }
    }
  }
}

#undef GEMM_LOAD
#undef UNIT_DECODE
namespace pg8 {
#define PG8_LAS __attribute__((address_space(3)))
typedef unsigned short bf16_t;
typedef short bf16x8 __attribute__((ext_vector_type(8)));
typedef _Float16 f16x8 __attribute__((ext_vector_type(8)));
typedef float f32x4 __attribute__((ext_vector_type(4)));
constexpr int BM = 256, BK = 64, HALF = 128, HTB = HALF * BK * 2  , STAGE_BYTES = 8 * HTB, NXCD = 8, WGM = 8;
__device__ __forceinline__ int lds_byte(int r, int c) { const int st = (r >> 4) * 2 + (c >> 5), rr = r & 15, cc = c & 31, ob = rr * 64 + cc * 2; return st * 1024 + (ob ^ (((ob >> 9) & 1) << 5)); }
__device__ __forceinline__ void stage_rc(int b, int& R, int& C) { const int st = b / 1024, sb = b % 1024, swz = sb ^ (((sb >> 9) & 1) << 5); R = (st >> 1) * 16 + swz / 64; C = (st & 1) * 32 + (swz % 64) / 2; }
__device__ __forceinline__ int perm32(int rho) { const int n = rho >> 4, i = rho & 15; return 8 * (i >> 2) + 4 * n + (i & 3); }
struct Unit { int pm, pn; };
struct Gemm { const bf16_t* A; const bf16_t* Bt; int M, N, K, lda; };
struct StaticOrder {
    int nM, nN, nwg, G, c;
    __device__ void init(int M, int N, int G_, int c_) { nM = M / BM; nN = N / BM; nwg = nM * nN; G = G_; c = c_; }
    __device__ bool next(int i, Unit& u) const {
        const long L = (long)i * G + c; if (L >= nwg) return false;
        int wgid = (int)L; { const int q = nwg / NXCD, r = nwg % NXCD, xcd = wgid % NXCD, off = wgid / NXCD; wgid = (xcd < r ? xcd * (q + 1) : r * (q + 1) + (xcd - r) * q) + off; }
        const int nig = WGM * nN, gid = wgid / nig, fm = gid * WGM, gsz = (nM - fm) < WGM ? (nM - fm) : WGM;
        u.pm = fm + ((wgid % nig) % gsz); u.pn = (wgid % nig) / gsz; return true;
    }
    __device__ __forceinline__ void a_ready(const Unit&) const {}
    __device__ __forceinline__ void done(const Unit&) const {}
};
template <class Epi, class Sched>
__device__ __forceinline__ void gemm_phase(PG8_LAS unsigned char* lds, const Gemm g, const Sched& S, const Epi& E) {
    const int tid = threadIdx.x, wid = __builtin_amdgcn_readfirstlane(tid >> 6), lane = tid & 63, wr = wid >> 2, wc = wid & 3, fr = lane & 15, fq = lane >> 4;
    const int K = g.K, nt = K / BK, lda = g.lda;
#define PG8_STAMP() do { } while (0)
    PG8_STAMP();
    unsigned voffA[2], voffB[2];
#pragma unroll
    for (int i = 0; i < 2; ++i) { int R, C; stage_rc(tid * 16 + i * 8192, R, C); const int Rb = Epi::PERM ? ((R & ~31) + perm32(R & 31)) : R;
        voffA[i] = (unsigned)(R * lda + C) * 2u; voffB[i] = (unsigned)(Rb * K + C) * 2u; }
    const size_t kstep = (size_t)(BK * 2);
    const size_t hstep = (size_t)HALF * K * 2, hstepA = (size_t)HALF * lda * 2;
    const size_t tstep = 2 * hstep, tstepA = 2 * hstepA;
    const unsigned ldsw = (unsigned)wid * 1024u;
    const int aoff = lds_byte(wr * 64 + fr, fq * 8), boff = lds_byte(wc * 32 + fr, fq * 8);
#define PG8_SA(b, h) (((b) * 2 + (h)) * HTB)
#define PG8_SB(b, h) ((4 + (b) * 2 + (h)) * HTB)
#define PG8_STAGE(bufoff, gbase, voff) do { _Pragma("unroll") for (int _i = 0; _i < 2; ++_i) \
        __builtin_amdgcn_global_load_lds((const unsigned*)((const char*)(gbase) + (voff)[_i]), (PG8_LAS unsigned*)(lds + (bufoff) + ldsw + _i * 8192), 16, 0, 0); } while (0)
#define PG8_LDA(dst, b, h) do { _Pragma("unroll") for (int m = 0; m < 4; ++m) _Pragma("unroll") for (int k = 0; k < 2; ++k) dst[m][k] = *(const PG8_LAS bf16x8*)(lds + PG8_SA(b, h) + aoff + m * 2048 + k * 1024); } while (0)
#define PG8_LDB(dst, b, h) do { _Pragma("unroll") for (int n = 0; n < 2; ++n) _Pragma("unroll") for (int k = 0; k < 2; ++k) dst[n][k] = *(const PG8_LAS bf16x8*)(lds + PG8_SB(b, h) + boff + n * 2048 + k * 1024); } while (0)
#define PG8_MMA(ai, bj, At, Bt) do { __builtin_amdgcn_s_setprio(1); _Pragma("unroll") for (int m = 0; m < 4; ++m) _Pragma("unroll") for (int n = 0; n < 2; ++n) _Pragma("unroll") for (int k = 0; k < 2; ++k) \
        acc[ai][bj][m][n] = __builtin_amdgcn_mfma_f32_16x16x32_f16(__builtin_bit_cast(f16x8, Bt[n][k]), __builtin_bit_cast(f16x8, At[m][k]), acc[ai][bj][m][n], 0, 0, 0); __builtin_amdgcn_s_setprio(0); } while (0)
#define PG8_WAIT_V(n) asm volatile("s_waitcnt vmcnt(" #n ")" ::: "memory")
#define PG8_WAIT_L(n) asm volatile("s_waitcnt lgkmcnt(" #n ")" ::: "memory")
#define PG8_BAR __builtin_amdgcn_s_barrier()
#define PG8_SCHED __builtin_amdgcn_sched_barrier(0)
    Unit cur, nxt; int ui = 0;
    if (!S.next(0, cur)) return;
    f32x4 acc[2][2][4][2];
#pragma unroll
    for (int a = 0; a < 2; ++a)
#pragma unroll
        for (int b = 0; b < 2; ++b)
#pragma unroll
            for (int m = 0; m < 4; ++m)
#pragma unroll
                for (int n = 0; n < 2; ++n) acc[a][b][m][n] = (f32x4){0.f, 0.f, 0.f, 0.f};
    bf16x8 At[4][2], B0[2][2], B1[2][2];
    const char* cA = (const char*)g.A + (size_t)cur.pm * tstepA; const char* cB = (const char*)g.Bt + (size_t)cur.pn * tstep;
    S.a_ready(cur);
    PG8_STAGE(PG8_SB(0, 0), cB, voffB); PG8_STAGE(PG8_SA(0, 0), cA, voffA); PG8_STAGE(PG8_SB(0, 1), cB + hstep, voffB); PG8_STAGE(PG8_SA(0, 1), cA + hstepA, voffA);
    if (wr == 1) PG8_BAR;
    PG8_WAIT_V(4); PG8_BAR;
    PG8_STAGE(PG8_SB(1, 0), cB + kstep, voffB); PG8_STAGE(PG8_SA(1, 0), cA + kstep, voffA); PG8_STAGE(PG8_SB(1, 1), cB + hstep + kstep, voffB);
    PG8_WAIT_V(6); PG8_BAR;
    PG8_STAMP();
    for (;;) {
        const bool has_next = S.next(ui + 1, nxt);
        const char* nA = has_next ? (const char*)g.A + (size_t)nxt.pm * tstepA : cA; const char* nB = has_next ? (const char*)g.Bt + (size_t)nxt.pn * tstep : cB;
        for (int t = 0; t < nt; t += 2) {
            const bool last = (t == nt - 2);
            const char* a1 = cA + (size_t)(t + 1) * kstep;
            const char* a2 = last ? nA : cA + (size_t)(t + 2) * kstep; const char* b2 = last ? nB : cB + (size_t)(t + 2) * kstep;
            const char* a3 = a2 + kstep; const char* b3 = b2 + kstep;
            if (last && has_next) S.a_ready(nxt);
            PG8_LDB(B0, 0, 0); PG8_SCHED; PG8_LDA(At, 0, 0); PG8_STAGE(PG8_SA(1, 1), a1 + hstepA, voffA);
            PG8_WAIT_L(8); PG8_BAR; PG8_WAIT_L(0); PG8_MMA(0, 0, At, B0); PG8_BAR; PG8_SCHED;
            PG8_LDB(B1, 0, 1); PG8_STAGE(PG8_SB(0, 0), b2, voffB);
            PG8_BAR; PG8_WAIT_L(0); PG8_MMA(0, 1, At, B1); PG8_BAR;
            PG8_LDA(At, 0, 1); PG8_STAGE(PG8_SA(0, 0), a2, voffA);
            PG8_BAR; PG8_WAIT_L(0); PG8_MMA(1, 0, At, B0); PG8_BAR; PG8_SCHED;
            PG8_STAGE(PG8_SB(0, 1), b2 + hstep, voffB);
            PG8_WAIT_V(6); PG8_BAR; PG8_MMA(1, 1, At, B1); PG8_BAR;
            PG8_LDB(B0, 1, 0); PG8_SCHED; PG8_LDA(At, 1, 0); PG8_STAGE(PG8_SA(0, 1), a2 + hstepA, voffA);
            PG8_WAIT_L(8); PG8_BAR; PG8_WAIT_L(0); PG8_MMA(0, 0, At, B0); PG8_BAR; PG8_SCHED;
            PG8_LDB(B1, 1, 1); PG8_STAGE(PG8_SB(1, 0), b3, voffB);
            PG8_BAR; PG8_WAIT_L(0); PG8_MMA(0, 1, At, B1); PG8_BAR;
            PG8_LDA(At, 1, 1); PG8_STAGE(PG8_SA(1, 0), a3, voffA);
            PG8_BAR; PG8_WAIT_L(0); PG8_MMA(1, 0, At, B0); PG8_BAR; PG8_SCHED;
            PG8_STAGE(PG8_SB(1, 1), b3 + hstep, voffB);
            PG8_WAIT_V(6); PG8_BAR; PG8_MMA(1, 1, At, B1); PG8_BAR;
        }
        PG8_STAMP();
        if constexpr (!Epi::AFTER_DRAIN) { E(acc, cur, wr, wc, fr, fq); S.done(cur); }
        PG8_STAMP();
        if (!has_next) break;
#pragma unroll
        for (int a = 0; a < 2; ++a)
#pragma unroll
            for (int b = 0; b < 2; ++b)
#pragma unroll
                for (int m = 0; m < 4; ++m)
#pragma unroll
                    for (int n = 0; n < 2; ++n) acc[a][b][m][n] = (f32x4){0.f, 0.f, 0.f, 0.f};
        cur = nxt; cA = nA; cB = nB; ++ui;
    }
    PG8_WAIT_V(0);
    if (wr == 0) PG8_BAR;
    PG8_BAR;
    if constexpr (Epi::AFTER_DRAIN) { E.fused(acc, cur, wr, wc, fr, fq, lds, wid, lane); S.done(cur); }
    PG8_STAMP();
#undef PG8_STAMP
#undef PG8_SA
#undef PG8_SB
#undef PG8_STAGE
#undef PG8_LDA
#undef PG8_LDB
#undef PG8_MMA
#undef PG8_WAIT_V
#undef PG8_WAIT_L
#undef PG8_BAR
#undef PG8_SCHED
}
}

struct EpiProj {
  static constexpr bool PERM = true, AFTER_DRAIN = false;
  _Float16* P1; _Float16* P2;
  __device__ __forceinline__ void operator()(const pg8::f32x4 (&acc)[2][2][4][2], const pg8::Unit& u, int wr, int wc, int fr, int fq) const {
    const int row0 = u.pm * 256 + wr * 64 + fr;
    if (u.pn >= 8 && u.pn < 16) {
      const bool cu = u.pn < 12;
      const int dcol = (cu ? 1024 + ((u.pn - 8) * 128) : 512 + ((u.pn - 12) * 128)) + wc * 16 + 4 * fq;
#pragma unroll
      for (int ai = 0; ai < 2; ++ai)
#pragma unroll
        for (int m = 0; m < 4; ++m) {
          _Float16* rowp = P2 + (size_t)(row0 + ai * 128 + m * 16) * LD2 + dcol;
#pragma unroll
          for (int bj = 0; bj < 2; ++bj) {
            h4 o;
#pragma unroll
            for (int q = 0; q < 4; ++q) {
              const float x0 = acc[ai][bj][m][q >> 1][(q & 1) * 2], x1 = acc[ai][bj][m][q >> 1][(q & 1) * 2 + 1];
              o[q] = (_Float16)(cu ? x0 * x1 : x0 * siluf_(x1));
            }
            __builtin_nontemporal_store(o, (h4*)(rowp + bj * 64));
          }
        }
      return;
    }
    _Float16* dst; int ldd, dcol; bool tanh0 = false;
    if (u.pn < 6) { dst = P1; ldd = LD1; dcol = u.pn * 256; }
    else if (u.pn < 8) { dst = P2; ldd = LD2; dcol = u.pn * 256 - 1536; }
    else { dst = P1; ldd = LD1; dcol = 1536; tanh0 = true; }
    const int col0 = dcol + wc * 32 + 8 * fq;
#pragma unroll
    for (int ai = 0; ai < 2; ++ai)
#pragma unroll
      for (int m = 0; m < 4; ++m) {
        _Float16* rowp = dst + (size_t)(row0 + ai * 128 + m * 16) * ldd + col0;
#pragma unroll
        for (int bj = 0; bj < 2; ++bj) {
          h8 o;
#pragma unroll
          for (int q = 0; q < 8; ++q) {
            float v = acc[ai][bj][m][q >> 2][q & 3];
            if (tanh0 && bj == 0) v = 1.f - 2.f * __builtin_amdgcn_rcpf(__expf(2.f * v) + 1.f);
            o[q] = (_Float16)v;
          }
          if (dst == P2) __builtin_nontemporal_store(o, (h8*)(rowp + bj * 128)); else *(h8*)(rowp + bj * 128) = o;
        }
      }
  }
};
struct EpiOut {
  static constexpr bool PERM = true, AFTER_DRAIN = false;
  const float* x_prompt; const float* x_sample; const float* MOD; _Float16* Z;
  __device__ __forceinline__ void operator()(const pg8::f32x4 (&acc)[2][2][4][2], const pg8::Unit& u, int wr, int wc, int fr, int fq) const {
    const int m0 = u.pm * 256;
    const float* xbase = m0 < NCTX ? x_prompt + (size_t)m0 * DM : x_sample + (size_t)(m0 - NCTX) * DM;
    _Float16* zbase = Z + (size_t)m0 * DM;
    const int mb = m0 < NCTX ? 0 : 1 + ((m0 - NCTX) >> 12);
    const unsigned col0 = (unsigned)(u.pn * 256 + wc * 32 + 8 * fq);
    const float* gp = MOD + mb * 3072 + 2048;
    const unsigned row0 = (unsigned)(wr * 64 + fr);
    f4 gk[2][2];
#pragma unroll
    for (int bj = 0; bj < 2; ++bj) { gk[bj][0] = *(const f4*)(gp + (col0 + bj * 128)); gk[bj][1] = *(const f4*)(gp + (col0 + bj * 128 + 4)); }
#pragma unroll
    for (int ai = 0; ai < 2; ++ai)
#pragma unroll
      for (int m = 0; m < 4; ++m) {
        const unsigned ro = (row0 + ai * 128 + m * 16) * DM + col0;
#pragma unroll
        for (int bj = 0; bj < 2; ++bj) {
          const f4 x0 = __builtin_nontemporal_load((const f4*)(xbase + (ro + bj * 128))), x1 = __builtin_nontemporal_load((const f4*)(xbase + (ro + bj * 128 + 4)));
          const f4 g0 = gk[bj][0], g1 = gk[bj][1];
          const f4 z0 = x0 + g0 * acc[ai][bj][m][0], z1 = x1 + g1 * acc[ai][bj][m][1];
          h8 o;
#pragma unroll
          for (int q = 0; q < 4; ++q) { o[q] = (_Float16)z0[q]; o[4 + q] = (_Float16)z1[q]; }
          *(h8*)(zbase + (ro + bj * 128)) = o;
        }
      }
  }
};

constexpr int SC_S = 0, SC_W = 2 * 5 * 2048, SC_A = SC_W + 4 * 2048, SC_Y = SC_A + 2 * 2048, SC_C = SC_Y + 1024, SC_G = SC_C + 384, SC_END = SC_G + 256;
template <int DIR>
__device__ __forceinline__ void scan_item(const Params& p, bool is_lat, int b, int h, int half, unsigned char* smem) {
  constexpr int e = DIR;
  int t0 = threadIdx.x; asm volatile("" : "+v"(t0));
  const int w = __builtin_amdgcn_readfirstlane(t0 >> 6);
  const int lane = t0 & 63;
  float* Sb = (float*)smem + SC_S;
  float* Wb = (float*)smem + SC_W;
  float* Ab = (float*)smem + SC_A;
  _Float16* Yb = (_Float16*)((float*)smem + SC_Y);
  float* Cb = (float*)smem + SC_C;
  float* Gb = (float*)smem + SC_G;
  const int T = is_lat ? 4096 : 256;
  const int RLm = is_lat ? 63 : 255;
  const int tok0 = is_lat ? NCTX + b * 4096 : b * 256;
  const int nch = T >> 5;
  if (t0 < 384) {
    const int arr = t0 >> 6, cc = t0 & 63;
    const float* src = arr < 3 ? p.shift_mu + arr * 512 : (arr == 3 ? p.kk_scale : (arr == 4 ? p.ka_scale : p.bonus_rk));
    Cb[t0] = src[h * 64 + cc];
  }
  const int rl = (w & 3) * 8 + (lane >> 3);
  const int irow = half * 32 + rl;
  const int g = lane & 7;
  f2 S0 = (f2){0.f, 0.f}, S1 = S0, S2 = S0, S3 = S0;
  if (is_lat && w < 4) {
    const float* sp = p.state + ((size_t)((b * 2 + e) * 8 + h)) * 4096 + irow * 64 + g * 8;
    f4 s0 = *(const f4*)(sp), s1 = *(const f4*)(sp + 4);
    S0 = (f2){s0[0], s0[1]}; S1 = (f2){s0[2], s0[3]}; S2 = (f2){s1[0], s1[1]}; S3 = (f2){s1[2], s1[3]};
  }
  const int yq = (t0 & 255) >> 3, yr4 = (t0 & 7) * 4;
  _Float16* yout = p.HY + ((size_t)e * NT + tok0 + yq) * 512 + h * 64 + half * 32 + yr4;
  const int pt = t0 & 255;
  const int eq = pt >> 3, ecg = pt & 7;
  const int hc = h * 64 + ecg * 8;
  const int which = w & 1, tt = (w >> 1) & 1;
  h8 pr[3][3];
  h8 pa[2];
  h8 bfr[4][2];
  float bias[4];
  if (w >= 4) {
    const unsigned uoff = (unsigned)(((e * 2 + which) * 512 + h * 64 + (lane & 15)) * 64 + (lane >> 4) * 8);
    const float* bp = (which ? p.iclr_bias : p.decay_w0) + (unsigned)(e * 512 + h * 64 + (lane & 15));
#pragma unroll
    for (int ct = 0; ct < 4; ++ct) {
      bfr[ct][0] = *(const h8*)(p.UPT + (uoff + ct * 16 * 64));
      bfr[ct][1] = *(const h8*)(p.UPT + (uoff + ct * 16 * 64 + 32));
      bias[ct] = bp[ct * 16];
    }
  }
#define TB_OF(C) (DIR == 0 ? (C) * 32 : T - 32 - (C) * 32)
#define PREFETCH_PA(C)                                                                             \
  { const unsigned aoff_ = (unsigned)((tok0 + TB_OF(C) + tt * 16 + (lane & 15)) * LD1 + 1536 + which * 128 + e * 64 + (lane >> 4) * 8); \
    pa[0] = *(const h8*)(p.P1 + aoff_); pa[1] = *(const h8*)(p.P1 + (aoff_ + 32)); }
#define PREFETCH_PR(C)                                                                             \
  { const int t_ = TB_OF(C) + eq;                                                                  \
    const unsigned off_ = (unsigned)((tok0 + t_) * LD1 + hc);                                      \
    const bool pv_ = (t_ & RLm) != 0, nv_ = (t_ & RLm) != RLm;                                     \
    _Pragma("unroll") for (int s_ = 0; s_ < 3; ++s_) {                                             \
      pr[s_][0] = *(const h8*)(p.P1 + (off_ + s_ * 512));                                          \
      pr[s_][1] = pv_ ? *(const h8*)(p.P1 + (off_ + s_ * 512 - LD1)) : (h8){0, 0, 0, 0, 0, 0, 0, 0}; \
      pr[s_][2] = nv_ ? *(const h8*)(p.P1 + (off_ + s_ * 512 + LD1)) : (h8){0, 0, 0, 0, 0, 0, 0, 0}; \
    } }
  if (w >= 4) PREFETCH_PA(0)
  __syncthreads();
#pragma unroll 1
  for (int i = 0; i < nch + 2; ++i) {
    if (w >= 4) {
      if (i < nch) {
        float* lamb = Wb + (i & 1) * 2048;
        float* wlb = Wb + 4096 + (i & 1) * 2048;
        float* ab_ = Ab + (i & 1) * 2048;
        const int G_ = lane >> 4;
#pragma unroll
        for (int ct = 0; ct < 4; ++ct) {
          f4 acc = (f4){0.f, 0.f, 0.f, 0.f};
          acc = __builtin_amdgcn_mfma_f32_16x16x32_f16(pa[0], bfr[ct][0], acc, 0, 0, 0);
          acc = __builtin_amdgcn_mfma_f32_16x16x32_f16(pa[1], bfr[ct][1], acc, 0, 0, 0);
          if (which) {
#pragma unroll
            for (int r = 0; r < 4; ++r) ab_[(tt * 16 + G_ * 4 + r) * 64 + ct * 16 + (lane & 15)] = sigmoidf_(acc[r] + bias[ct]);
          } else {
            float wl[4], lam[4];
#pragma unroll
            for (int r = 0; r < 4; ++r) wl[r] = -0.8750387749f * sigmoidf_(acc[r] + bias[ct]);
            if (DIR == 0) { lam[0] = wl[0]; lam[1] = lam[0] + wl[1]; lam[2] = lam[1] + wl[2]; lam[3] = lam[2] + wl[3]; }
            else { lam[3] = wl[3]; lam[2] = lam[3] + wl[2]; lam[1] = lam[2] + wl[1]; lam[0] = lam[1] + wl[0]; }
            const float tot = DIR == 0 ? lam[3] : lam[0];
            const float t0_ = __shfl(tot, (lane & 15)), t1_ = __shfl(tot, (lane & 15) + 16), t2_ = __shfl(tot, (lane & 15) + 32), t3_ = __shfl(tot, (lane & 15) + 48);
            float E_;
            if (DIR == 0) E_ = (G_ > 0 ? t0_ : 0.f) + (G_ > 1 ? t1_ : 0.f) + (G_ > 2 ? t2_ : 0.f);
            else E_ = (G_ < 1 ? t1_ : 0.f) + (G_ < 2 ? t2_ : 0.f) + (G_ < 3 ? t3_ : 0.f);
#pragma unroll
            for (int r = 0; r < 4; ++r) {
              const int o_ = (tt * 16 + G_ * 4 + r) * 64 + ct * 16 + (lane & 15);
              lamb[o_] = E_ + lam[r]; wlb[o_] = wl[r];
            }
          }
        }
        if (i + 1 < nch) PREFETCH_PA(i + 1)
      }
      if (i >= 1 && i <= nch) {
        const int c = i - 1;
        const float* cb = Cb + ecg * 8;
        const float* ab = Ab + (c & 1) * 2048 + eq * 64 + ecg * 8;
        const float* lmb = Wb + (c & 1) * 2048 + eq * 64 + ecg * 8;
        const float* wlb = Wb + 4096 + (c & 1) * 2048 + eq * 64 + ecg * 8;
        const bool glast = DIR == 0 ? ((eq & 15) == 15) : ((eq & 15) == 0);
        float* o0 = Sb + (c & 1) * 10240 + eq * 64 + ecg * 8;
        float ksft[8], ssq = 0.f;
#pragma unroll
        for (int q = 0; q < 8; ++q) {
          const float x = (float)pr[1][0][q], xp = (float)pr[1][1][q], xn = (float)pr[1][2][q];
          ksft[q] = x + cb[64 + q] * (0.5f * (xp + xn) - x);
          const float kkr = ksft[q] * cb[192 + q];
          ssq += kkr * kkr;
        }
        ssq = red8(ssq);
        const float rn = rsqrtf(fmaxf(ssq, 1e-24f));
        float bo = 0.f;
#pragma unroll
        for (int hq = 0; hq < 2; ++hq) {
          f4 kk, bb, kd, rs, vs;
          const f4 a4 = *(const f4*)(ab + hq * 4);
          const f4 lm4 = *(const f4*)(lmb + hq * 4), wl4 = *(const f4*)(wlb + hq * 4);
          f4 gcur4;
#pragma unroll
          for (int qq = 0; qq < 4; ++qq) {
            const int q = hq * 4 + qq;
            float x = (float)pr[0][0][q], xp = (float)pr[0][1][q], xn = (float)pr[0][2][q];
            rs[qq] = x + cb[q] * (0.5f * (xp + xn) - x);
            x = (float)pr[2][0][q]; xp = (float)pr[2][1][q]; xn = (float)pr[2][2][q];
            vs[qq] = x + cb[128 + q] * (0.5f * (xp + xn) - x);
            const float kkv = ksft[q] * cb[192 + q] * rn;
            const float kdv = ksft[q] * (1.f + (a4[qq] - 1.f) * cb[256 + q]);
            bo += rs[qq] * kdv * cb[320 + q];
            const float gprev = __builtin_amdgcn_exp2f(lm4[qq] - wl4[qq]), ginv = __builtin_amdgcn_exp2f(-lm4[qq]), gcur = __builtin_amdgcn_exp2f(lm4[qq]);
            kk[qq] = kkv * gprev; bb[qq] = kkv * a4[qq] * ginv; kd[qq] = kdv * ginv; rs[qq] *= gcur; gcur4[qq] = gcur;
          }
          *(f4*)(o0 + hq * 4) = kk;
          *(f4*)(o0 + 2048 + hq * 4) = bb;
          *(f4*)(o0 + 4096 + hq * 4) = kd;
          *(f4*)(o0 + 6144 + hq * 4) = rs;
          *(f4*)(o0 + 8192 + hq * 4) = vs;
          if (glast) *(f4*)(Gb + (c & 1) * 128 + (eq >> 4) * 64 + ecg * 8 + hq * 4) = gcur4;
        }
        bo = red8(bo);
        if (half == 0 && ecg == 0) p.BON[(unsigned)((e * NT + tok0 + TB_OF(c) + eq) * 8 + h)] = bo;
      }
      if (i < nch) PREFETCH_PR(i)
    } else {
      if (i >= 3) *(h4*)(yout + (size_t)TB_OF(i - 3) * 512) = *(const h4*)(Yb + ((i - 3) & 1) * 1024 + yq * 32 + yr4);
      if (i >= 2) {
        const int c = i - 2;
        const float* Sc = Sb + (c & 1) * 10240;
        const float* Gc = Gb + (c & 1) * 128;
        _Float16* Yc = Yb + (c & 1) * 1024;
#pragma unroll 1
        for (int so = 0; so < 2; ++so) {
          const int qb = DIR == 0 ? so * 16 : 16 - so * 16;
          const float* Lb = Sc + qb * 64 + g * 8;
          const float* Lv = Sc + 8192 + qb * 64 + irow;
#define STEP_OFF(SI) ((DIR == 0 ? (SI) : 15 - (SI)) * 64)
          float cY = 0.f;
          f4 ka = *(const f4*)(Lb + STEP_OFF(0)), kb = *(const f4*)(Lb + 4 + STEP_OFF(0));
          f4 ba = *(const f4*)(Lb + 2048 + STEP_OFF(0)), bb_ = *(const f4*)(Lb + 2048 + 4 + STEP_OFF(0));
          f4 da = *(const f4*)(Lb + 4096 + STEP_OFF(0)), db = *(const f4*)(Lb + 4096 + 4 + STEP_OFF(0));
          f4 ra = *(const f4*)(Lb + 6144 + STEP_OFF(0)), rb_ = *(const f4*)(Lb + 6144 + 4 + STEP_OFF(0));
          float vv = Lv[STEP_OFF(0)];
#pragma unroll
          for (int si = 0; si < 16; ++si) {
            f4 nka, nkb, nba, nbb, nda, ndb, nra, nrb; float nvv;
            if (si < 15) {
              const int o = STEP_OFF(si + 1);
              nka = *(const f4*)(Lb + o); nkb = *(const f4*)(Lb + 4 + o);
              nba = *(const f4*)(Lb + 2048 + o); nbb = *(const f4*)(Lb + 2048 + 4 + o);
              nda = *(const f4*)(Lb + 4096 + o); ndb = *(const f4*)(Lb + 4096 + 4 + o);
              nra = *(const f4*)(Lb + 6144 + o); nrb = *(const f4*)(Lb + 6144 + 4 + o);
              nvv = Lv[o];
            }
            f2 dk = S0 * (f2){ka[0], ka[1]} + S1 * (f2){ka[2], ka[3]} + S2 * (f2){kb[0], kb[1]} + S3 * (f2){kb[2], kb[3]};
            const float sk = red8(dk[0] + dk[1]);
            const f2 nk2 = (f2){-sk, -sk}, v2_ = (f2){vv, vv};
            S0 = S0 + nk2 * (f2){ba[0], ba[1]} + v2_ * (f2){da[0], da[1]};
            S1 = S1 + nk2 * (f2){ba[2], ba[3]} + v2_ * (f2){da[2], da[3]};
            S2 = S2 + nk2 * (f2){bb_[0], bb_[1]} + v2_ * (f2){db[0], db[1]};
            S3 = S3 + nk2 * (f2){bb_[2], bb_[3]} + v2_ * (f2){db[2], db[3]};
            f2 dy = S0 * (f2){ra[0], ra[1]} + S1 * (f2){ra[2], ra[3]} + S2 * (f2){rb_[0], rb_[1]} + S3 * (f2){rb_[2], rb_[3]};
            const float yv = red8(dy[0] + dy[1]);
            cY = (g == (si & 7)) ? yv : cY;
            if ((si & 7) == 7) {
              const int st = so * 16 + (si - 7) + g;
              const int qq = DIR == 0 ? st : 31 - st;
              Yc[qq * 32 + rl] = (_Float16)(cY * 0.0625f);
            }
            if (si < 15) { ka = nka; kb = nkb; ba = nba; bb_ = nbb; da = nda; db = ndb; ra = nra; rb_ = nrb; vv = nvv; }
          }
#undef STEP_OFF
          { const f4 ga = *(const f4*)(Gc + (qb >> 4) * 64 + g * 8), gb = *(const f4*)(Gc + (qb >> 4) * 64 + g * 8 + 4);
            S0 = S0 * (f2){ga[0], ga[1]}; S1 = S1 * (f2){ga[2], ga[3]}; S2 = S2 * (f2){gb[0], gb[1]}; S3 = S3 * (f2){gb[2], gb[3]}; }
        }
      }
    }
    __syncthreads();
  }
  if (w < 4) {
    *(h4*)(yout + (size_t)TB_OF(nch - 1) * 512) = *(const h4*)(Yb + ((nch - 1) & 1) * 1024 + yq * 32 + yr4);
    if (!is_lat) {
      float* op = p.out + (size_t)NT * DM + ((size_t)((b * 2 + e) * 8 + h)) * 4096 + irow * 64 + g * 8;
      *(f4*)(op) = (f4){S0[0], S0[1], S1[0], S1[1]};
      *(f4*)(op + 4) = (f4){S2[0], S2[1], S3[0], S3[1]};
    }
  }
#undef TB_OF
#undef PREFETCH_PA
#undef PREFETCH_PR
  __syncthreads();
}

template <int DIR>
__device__ __forceinline__ void scan_stream2(const Params& p, int cbase, int h, int half, unsigned char* smem) {
  constexpr int e = DIR;
  int t0 = threadIdx.x; asm volatile("" : "+v"(t0));
  const int w = __builtin_amdgcn_readfirstlane(t0 >> 6);
  const int lane = t0 & 63;
  float* Sb = (float*)smem + SC_S;
  float* Wb = (float*)smem + SC_W;
  float* Ab = (float*)smem + SC_A;
  _Float16* Yb = (_Float16*)((float*)smem + SC_Y);
  float* Cb = (float*)smem + SC_C;
  _Float16* Ch = (_Float16*)((float*)smem + SC_END);
  float* Gb = (float*)smem + SC_G;
  constexpr int NCHUNK = 128 + 4 * 8;
#define CD_LAT(N) ((N) < 128)
#define CD_C(N) (CD_LAT(N) ? (N) : (((N) - 128) & 7))
#define CD_B(N) (((CD_LAT(N) ? 0 : ((((N) - 128) >> 3) * 128)) + cbase) >> 4)
#define CD_T(N) (CD_LAT(N) ? 4096 : 256)
#define CD_RLM(N) (CD_LAT(N) ? 63 : 255)
#define CD_TOK0(N) (CD_LAT(N) ? NCTX + CD_B(N) * 4096 : CD_B(N) * 256)
#define CD_FIRST(N) (CD_C(N) == 0)
#define CD_LAST(N) (CD_C(N) == (CD_LAT(N) ? 127 : 7))
  if (t0 < 384) {
    const int arr = t0 >> 6, cc = t0 & 63;
    const float* src = arr < 3 ? p.shift_mu + arr * 512 : (arr == 3 ? p.kk_scale : (arr == 4 ? p.ka_scale : p.bonus_rk));
    const float cv_ = src[h * 64 + cc];
    Cb[t0] = cv_;
    if (arr < 3) Ch[t0] = (_Float16)cv_;
  }
  const int rl = (w & 3) * 8 + (lane >> 3);
  const int irow = half * 32 + rl;
  const int g = lane & 7;
  f2 S0 = (f2){0.f, 0.f}, S1 = S0, S2 = S0, S3 = S0;
  const int yq = (t0 & 255) >> 3, yr4 = (t0 & 7) * 4;
  _Float16* yout = p.HY + ((size_t)e * NT + yq) * 512 + h * 64 + half * 32 + yr4;
  const int pt = t0 & 255;
  const int eq = pt >> 3, ecg = pt & 7;
  const int hc = h * 64 + ecg * 8;
  const int tt = w & 1, cp = (w >> 1) & 1;
  h8 pr[3][3];
  h8 pa[2][2];
  h8 bfr[2][2][2];
  float bias[2][2];
  if (w >= 4) {
#pragma unroll
    for (int wh = 0; wh < 2; ++wh) {
      const unsigned uoff = (unsigned)(((e * 2 + wh) * 512 + h * 64 + cp * 32 + (lane & 15)) * 64 + (lane >> 4) * 8);
      const float* bp = (wh ? p.iclr_bias : p.decay_w0) + (unsigned)(e * 512 + h * 64 + cp * 32 + (lane & 15));
#pragma unroll
      for (int c2 = 0; c2 < 2; ++c2) {
        bfr[wh][c2][0] = *(const h8*)(p.UPT + (uoff + c2 * 16 * 64));
        bfr[wh][c2][1] = *(const h8*)(p.UPT + (uoff + c2 * 16 * 64 + 32));
        bias[wh][c2] = bp[c2 * 16];
      }
    }
  }
#define TB_OF(N) (DIR == 0 ? CD_C(N) * 32 : CD_T(N) - 32 - CD_C(N) * 32)
#define PREFETCH_PA(C)                                                                             \
  { const unsigned aoff_ = (unsigned)((CD_TOK0(C) + TB_OF(C) + tt * 16 + (lane & 15)) * LD1 + 1536 + e * 64 + (lane >> 4) * 8); \
    pa[0][0] = *(const h8*)(p.P1 + aoff_); pa[0][1] = *(const h8*)(p.P1 + (aoff_ + 32));                                    \
    pa[1][0] = *(const h8*)(p.P1 + (aoff_ + 128)); pa[1][1] = *(const h8*)(p.P1 + (aoff_ + 160)); }
#define PREFETCH_PR(C)                                                                             \
  { const int t_ = TB_OF(C) + eq;                                                                  \
    const unsigned off_ = (unsigned)((CD_TOK0(C) + t_) * LD1 + hc);                                \
    const bool pv_ = (t_ & CD_RLM(C)) != 0, nv_ = (t_ & CD_RLM(C)) != CD_RLM(C);                   \
    _Pragma("unroll") for (int s_ = 0; s_ < 3; ++s_) {                                             \
      pr[s_][0] = *(const h8*)(p.P1 + (off_ + s_ * 512));                                          \
      pr[s_][1] = pv_ ? *(const h8*)(p.P1 + (off_ + s_ * 512 - LD1)) : (h8){0, 0, 0, 0, 0, 0, 0, 0}; \
      pr[s_][2] = nv_ ? *(const h8*)(p.P1 + (off_ + s_ * 512 + LD1)) : (h8){0, 0, 0, 0, 0, 0, 0, 0}; \
    } }
  if (w >= 4) PREFETCH_PA(0)
  __syncthreads();
#pragma unroll 1
  for (int i = 0; i < NCHUNK + 2; ++i) {
    if (w >= 4) {
      if (i < NCHUNK) {
        const int G_ = lane >> 4;
        const int rowbase = (tt * 16 + G_ * 4) * 64 + cp * 32 + (lane & 15);
        float* lp = Wb + (i & 1) * 2048 + rowbase;
        float* wp = Wb + 4096 + (i & 1) * 2048 + rowbase;
        float* ap = Ab + (i & 1) * 2048 + rowbase;
#define SIG2(X, OUT) { const f2 t_ = (X) * (f2){-1.44269504f, -1.44269504f};                                       \
                       const f2 e_ = (f2){__builtin_amdgcn_exp2f(t_[0]), __builtin_amdgcn_exp2f(t_[1])} + (f2){1.f, 1.f}; \
                       OUT = (f2){__builtin_amdgcn_rcpf(e_[0]), __builtin_amdgcn_rcpf(e_[1])}; }
#pragma unroll
        for (int c2 = 0; c2 < 2; ++c2) {
          {
            f4 acc = (f4){0.f, 0.f, 0.f, 0.f};
            acc = __builtin_amdgcn_mfma_f32_16x16x32_f16(pa[1][0], bfr[1][c2][0], acc, 0, 0, 0);
            acc = __builtin_amdgcn_mfma_f32_16x16x32_f16(pa[1][1], bfr[1][c2][1], acc, 0, 0, 0);
            const f2 bb2 = (f2){bias[1][c2], bias[1][c2]};
            f2 s01, s23;
            SIG2(((f2){acc[0], acc[1]} + bb2), s01)
            SIG2(((f2){acc[2], acc[3]} + bb2), s23)
            ap[0 * 64 + c2 * 16] = s01[0]; ap[1 * 64 + c2 * 16] = s01[1]; ap[2 * 64 + c2 * 16] = s23[0]; ap[3 * 64 + c2 * 16] = s23[1];
          }
          {
            f4 acc = (f4){0.f, 0.f, 0.f, 0.f};
            acc = __builtin_amdgcn_mfma_f32_16x16x32_f16(pa[0][0], bfr[0][c2][0], acc, 0, 0, 0);
            acc = __builtin_amdgcn_mfma_f32_16x16x32_f16(pa[0][1], bfr[0][c2][1], acc, 0, 0, 0);
            const f2 bb2 = (f2){bias[0][c2], bias[0][c2]};
            f2 s01, s23;
            SIG2(((f2){acc[0], acc[1]} + bb2), s01)
            SIG2(((f2){acc[2], acc[3]} + bb2), s23)
            const f2 a01 = s01 * (f2){-0.8750387749f, -0.8750387749f}, a23 = s23 * (f2){-0.8750387749f, -0.8750387749f};
            float wd[4], gam[4], gex[4];
            wd[0] = __builtin_amdgcn_exp2f(a01[0]); wd[1] = __builtin_amdgcn_exp2f(a01[1]); wd[2] = __builtin_amdgcn_exp2f(a23[0]); wd[3] = __builtin_amdgcn_exp2f(a23[1]);
            if (DIR == 0) { gex[0] = 1.f; gam[0] = wd[0]; gex[1] = gam[0]; gam[1] = gam[0] * wd[1]; gex[2] = gam[1]; gam[2] = gam[1] * wd[2]; gex[3] = gam[2]; gam[3] = gam[2] * wd[3]; }
            else { gex[3] = 1.f; gam[3] = wd[3]; gex[2] = gam[3]; gam[2] = gam[3] * wd[2]; gex[1] = gam[2]; gam[1] = gam[2] * wd[1]; gex[0] = gam[1]; gam[0] = gam[1] * wd[0]; }
            const float tot = DIR == 0 ? gam[3] : gam[0];
            const float t0_ = __shfl(tot, (lane & 15)), t1_ = __shfl(tot, (lane & 15) + 16), t2_ = __shfl(tot, (lane & 15) + 32), t3_ = __shfl(tot, (lane & 15) + 48);
            float E_;
            if (DIR == 0) E_ = (G_ > 0 ? t0_ : 1.f) * (G_ > 1 ? t1_ : 1.f) * (G_ > 2 ? t2_ : 1.f);
            else E_ = (G_ < 1 ? t1_ : 1.f) * (G_ < 2 ? t2_ : 1.f) * (G_ < 3 ? t3_ : 1.f);
            const f2 E2 = (f2){E_, E_};
            const f2 g01 = E2 * (f2){gam[0], gam[1]}, g23 = E2 * (f2){gam[2], gam[3]}, x01 = E2 * (f2){gex[0], gex[1]}, x23 = E2 * (f2){gex[2], gex[3]};
            lp[0 * 64 + c2 * 16] = g01[0]; lp[1 * 64 + c2 * 16] = g01[1]; lp[2 * 64 + c2 * 16] = g23[0]; lp[3 * 64 + c2 * 16] = g23[1];
            wp[0 * 64 + c2 * 16] = x01[0]; wp[1 * 64 + c2 * 16] = x01[1]; wp[2 * 64 + c2 * 16] = x23[0]; wp[3 * 64 + c2 * 16] = x23[1];
          }
        }
#undef SIG2
        if (i + 1 < NCHUNK) PREFETCH_PA(i + 1)
      }
      if (i >= 1 && i <= NCHUNK) {
        const int c = i - 1;
        const float* cb = Cb + ecg * 8;
        const float* ab = Ab + (c & 1) * 2048 + eq * 64 + ecg * 8;
        const float* lmb = Wb + (c & 1) * 2048 + eq * 64 + ecg * 8;
        const float* wlb = Wb + 4096 + (c & 1) * 2048 + eq * 64 + ecg * 8;
        const bool glast = DIR == 0 ? ((eq & 15) == 15) : ((eq & 15) == 0);
        float* o0 = Sb + (c & 1) * 10240 + eq * 64 + ecg * 8;
        const h8 hf8 = (h8){(_Float16)0.5f, (_Float16)0.5f, (_Float16)0.5f, (_Float16)0.5f, (_Float16)0.5f, (_Float16)0.5f, (_Float16)0.5f, (_Float16)0.5f};
        const h8 rs16 = pr[0][0] + *(const h8*)(Ch + ecg * 8) * ((pr[0][1] + pr[0][2]) * hf8 - pr[0][0]);
        const h8 ks16 = pr[1][0] + *(const h8*)(Ch + 64 + ecg * 8) * ((pr[1][1] + pr[1][2]) * hf8 - pr[1][0]);
        const h8 vs16 = pr[2][0] + *(const h8*)(Ch + 128 + ecg * 8) * ((pr[2][1] + pr[2][2]) * hf8 - pr[2][0]);
        float ksft[8], ssq = 0.f;
#pragma unroll
        for (int q = 0; q < 8; ++q) {
          ksft[q] = (float)ks16[q];
          const float kkr = ksft[q] * cb[192 + q];
          ssq += kkr * kkr;
        }
        ssq = red8(ssq);
        const float rn = rsqrtf(fmaxf(ssq, 1e-24f));
        float bo = 0.f;
#pragma unroll
        for (int hq = 0; hq < 2; ++hq) {
          f4 kk, bb, kd, rs, vs;
          const f4 a4 = *(const f4*)(ab + hq * 4);
          const f4 lm4 = *(const f4*)(lmb + hq * 4), wl4 = *(const f4*)(wlb + hq * 4);
          f4 gcur4;
#pragma unroll
          for (int qq = 0; qq < 4; ++qq) {
            const int q = hq * 4 + qq;
            rs[qq] = (float)rs16[q];
            vs[qq] = (float)vs16[q];
            const float kkv = ksft[q] * cb[192 + q] * rn;
            const float kdv = ksft[q] * (1.f + (a4[qq] - 1.f) * cb[256 + q]);
            bo += rs[qq] * kdv * cb[320 + q];
            const float gprev = wl4[qq], gcur = lm4[qq], ginv = __builtin_amdgcn_rcpf(gcur);
            kk[qq] = kkv * gprev; bb[qq] = kkv * a4[qq] * ginv; kd[qq] = kdv * ginv; rs[qq] *= gcur; gcur4[qq] = gcur;
          }
          *(f4*)(o0 + hq * 4) = kk;
          *(f4*)(o0 + 2048 + hq * 4) = bb;
          *(f4*)(o0 + 4096 + hq * 4) = kd;
          *(f4*)(o0 + 6144 + hq * 4) = rs;
          *(f4*)(o0 + 8192 + hq * 4) = vs;
          if (glast) *(f4*)(Gb + (c & 1) * 128 + (eq >> 4) * 64 + ecg * 8 + hq * 4) = gcur4;
        }
        bo = red8(bo);
        if (half == 0 && ecg == 0) p.BON[(unsigned)((e * NT + CD_TOK0(c) + TB_OF(c) + eq) * 8 + h)] = bo;
      }
      if (i < NCHUNK) PREFETCH_PR(i)
    } else {
      if (i >= 3) *(h4*)(yout + (size_t)(CD_TOK0(i - 3) + TB_OF(i - 3)) * 512) = *(const h4*)(Yb + ((i - 3) & 1) * 1024 + yq * 32 + yr4);
      if (i >= 2) {
        const int c = i - 2;
        if (CD_FIRST(c)) {
          if (CD_LAT(c)) {
            const float* sp = p.state + ((size_t)((CD_B(c) * 2 + e) * 8 + h)) * 4096 + irow * 64 + g * 8;
            f4 s0 = *(const f4*)(sp), s1 = *(const f4*)(sp + 4);
            S0 = (f2){s0[0], s0[1]}; S1 = (f2){s0[2], s0[3]}; S2 = (f2){s1[0], s1[1]}; S3 = (f2){s1[2], s1[3]};
          } else { S0 = (f2){0.f, 0.f}; S1 = S0; S2 = S0; S3 = S0; }
        }
        const float* Sc = Sb + (c & 1) * 10240;
        const float* Gc = Gb + (c & 1) * 128;
        _Float16* Yc = Yb + (c & 1) * 1024;
#pragma unroll 1
        for (int so = 0; so < 2; ++so) {
          const int qb = DIR == 0 ? so * 16 : 16 - so * 16;
          const float* Lb = Sc + qb * 64 + g * 8;
          const float* Lv = Sc + 8192 + qb * 64 + irow;
#define STEP_OFF(SI) ((DIR == 0 ? (SI) : 15 - (SI)) * 64)
          float cY = 0.f;
          f4 ka = *(const f4*)(Lb + STEP_OFF(0)), kb = *(const f4*)(Lb + 4 + STEP_OFF(0));
          f4 ba = *(const f4*)(Lb + 2048 + STEP_OFF(0)), bb_ = *(const f4*)(Lb + 2048 + 4 + STEP_OFF(0));
          f4 da = *(const f4*)(Lb + 4096 + STEP_OFF(0)), db = *(const f4*)(Lb + 4096 + 4 + STEP_OFF(0));
          f4 ra = *(const f4*)(Lb + 6144 + STEP_OFF(0)), rb_ = *(const f4*)(Lb + 6144 + 4 + STEP_OFF(0));
          float vv = Lv[STEP_OFF(0)];
#pragma unroll
          for (int si = 0; si < 16; ++si) {
            f4 nka, nkb, nba, nbb, nda, ndb, nra, nrb; float nvv;
            if (si < 15) {
              const int o = STEP_OFF(si + 1);
              nka = *(const f4*)(Lb + o); nkb = *(const f4*)(Lb + 4 + o);
              nba = *(const f4*)(Lb + 2048 + o); nbb = *(const f4*)(Lb + 2048 + 4 + o);
              nda = *(const f4*)(Lb + 4096 + o); ndb = *(const f4*)(Lb + 4096 + 4 + o);
              nra = *(const f4*)(Lb + 6144 + o); nrb = *(const f4*)(Lb + 6144 + 4 + o);
              nvv = Lv[o];
            }
            f2 dk = S0 * (f2){ka[0], ka[1]} + S1 * (f2){ka[2], ka[3]} + S2 * (f2){kb[0], kb[1]} + S3 * (f2){kb[2], kb[3]};
            const float sk = red8(dk[0] + dk[1]);
            const f2 nk2 = (f2){-sk, -sk}, v2_ = (f2){vv, vv};
            S0 = S0 + nk2 * (f2){ba[0], ba[1]} + v2_ * (f2){da[0], da[1]};
            S1 = S1 + nk2 * (f2){ba[2], ba[3]} + v2_ * (f2){da[2], da[3]};
            S2 = S2 + nk2 * (f2){bb_[0], bb_[1]} + v2_ * (f2){db[0], db[1]};
            S3 = S3 + nk2 * (f2){bb_[2], bb_[3]} + v2_ * (f2){db[2], db[3]};
            f2 dy = S0 * (f2){ra[0], ra[1]} + S1 * (f2){ra[2], ra[3]} + S2 * (f2){rb_[0], rb_[1]} + S3 * (f2){rb_[2], rb_[3]};
            const float yv = red8(dy[0] + dy[1]);
            cY = (g == (si & 7)) ? yv : cY;
            if ((si & 7) == 7) {
              const int st = so * 16 + (si - 7) + g;
              const int qq = DIR == 0 ? st : 31 - st;
              Yc[qq * 32 + rl] = (_Float16)(cY * 0.0625f);
            }
            if (si < 15) { ka = nka; kb = nkb; ba = nba; bb_ = nbb; da = nda; db = ndb; ra = nra; rb_ = nrb; vv = nvv; }
          }
#undef STEP_OFF
          { const f4 ga = *(const f4*)(Gc + (qb >> 4) * 64 + g * 8), gb = *(const f4*)(Gc + (qb >> 4) * 64 + g * 8 + 4);
            S0 = S0 * (f2){ga[0], ga[1]}; S1 = S1 * (f2){ga[2], ga[3]}; S2 = S2 * (f2){gb[0], gb[1]}; S3 = S3 * (f2){gb[2], gb[3]}; }
        }
        if (CD_LAST(c) && !CD_LAT(c)) {
          float* op = p.out + (size_t)NT * DM + ((size_t)((CD_B(c) * 2 + e) * 8 + h)) * 4096 + irow * 64 + g * 8;
          *(f4*)(op) = (f4){S0[0], S0[1], S1[0], S1[1]};
          *(f4*)(op + 4) = (f4){S2[0], S2[1], S3[0], S3[1]};
        }
      }
    }
    __syncthreads();
  }
  if (w < 4) *(h4*)(yout + (size_t)(CD_TOK0(NCHUNK - 1) + TB_OF(NCHUNK - 1)) * 512) = *(const h4*)(Yb + ((NCHUNK - 1) & 1) * 1024 + yq * 32 + yr4);
#undef TB_OF
#undef PREFETCH_PA
#undef PREFETCH_PR
#undef CD_LAT
#undef CD_C
#undef CD_B
#undef CD_T
#undef CD_RLM
#undef CD_TOK0
#undef CD_FIRST
#undef CD_LAST
  __syncthreads();
}

__device__ __forceinline__ bool scan_get_item(int it, bool& is_lat, int& chain, int& half) {
  const int G = gridDim.x, bid = blockIdx.x;
  int i;
  if (G >= 512) {
    if (bid < 256) { if (it > 0) return false; i = bid; }
    else { const int j = bid - 256 + it * (G - 256); if (j >= 1024) return false; i = 256 + j; }
  } else { i = bid + it * G; if (i >= 1280) return false; }
  if (i < 256) { is_lat = true; chain = (i >> 4) * 8 + (i & 7); half = (i >> 3) & 1; }
  else { const int j = i - 256, bp = j & 255, rnd = j >> 8; is_lat = false; chain = rnd * 128 + (bp >> 4) * 8 + (bp & 7); half = (bp >> 3) & 1; }
  return true;
}
__device__ __forceinline__ void scan_phase(const Params& p, unsigned char* smem) {
  if (gridDim.x == 256) {
    const int bid = blockIdx.x, cbase = (bid >> 4) * 8 + (bid & 7), h_ = cbase & 7, e_ = (cbase >> 3) & 1, half_ = (bid >> 3) & 1;
    if (e_ == 0) scan_stream2<0>(p, cbase, h_, half_, smem); else scan_stream2<1>(p, cbase, h_, half_, smem);
    return;
  }
  for (int it = 0;; ++it) {
    bool is_lat; int chain, half;
    if (!scan_get_item(it, is_lat, chain, half)) break;
    const int h = chain & 7, e = (chain >> 3) & 1, b = chain >> 4;
    if (e == 0) scan_item<0>(p, is_lat, b, h, half, smem); else scan_item<1>(p, is_lat, b, h, half, smem);
  }
}

__device__ __forceinline__ void ld8nt(const _Float16* ptr, float (&o)[8]) {
  h8 v = __builtin_nontemporal_load((const h8*)ptr);
#pragma unroll
  for (int q = 0; q < 8; ++q) o[q] = (float)v[q];
}
__device__ __forceinline__ void ld8(const _Float16* ptr, bool valid, float (&o)[8]) {
  h8 v = valid ? *(const h8*)ptr : (h8){0, 0, 0, 0, 0, 0, 0, 0};
#pragma unroll
  for (int q = 0; q < 8; ++q) o[q] = (float)v[q];
}
__device__ __forceinline__ void phase4(const Params& p) {
  int tid = threadIdx.x; asm volatile("" : "+v"(tid));
  const int lane = tid & 63, w = tid >> 6;
  const int c0 = lane * 8;
  f4 kmu[2], kgw[2], kgb[2], kw0[2], kw1[2], kw2[2];
#pragma unroll
  for (int hq = 0; hq < 2; ++hq) {
    kmu[hq] = *(const f4*)(p.shift_mu + 1024 + c0 + hq * 4); kgw[hq] = *(const f4*)(p.gn_w + c0 + hq * 4); kgb[hq] = *(const f4*)(p.gn_b + c0 + hq * 4);
    kw0[hq] = *(const f4*)(p.conv_w + c0 + hq * 4); kw1[hq] = *(const f4*)(p.conv_w + 512 + c0 + hq * 4); kw2[hq] = *(const f4*)(p.conv_w + 1024 + c0 + hq * 4);
  }
  for (int tok = blockIdx.x * 8 + w; tok < NT; tok += gridDim.x * 8) {
    const bool is_lat = tok >= NCTX;
    const int t = is_lat ? ((tok - NCTX) & 4095) : (tok & 255);
    const int RLm = is_lat ? 63 : 255;
    const bool pv = (t & RLm) != 0, nv = (t & RLm) != RLm;
    float y0[8], y1[8], ys[8];
    ld8nt(p.HY + (size_t)tok * 512 + c0, y0);
    ld8nt(p.HY + ((size_t)NT + tok) * 512 + c0, y1);
    float sum = 0.f;
#pragma unroll
    for (int q = 0; q < 8; ++q) { ys[q] = (y0[q] + y1[q]) * 16.f; sum += ys[q]; }
    sum = red8(sum);
    const float mean = sum * (1.f / 64.f);
    float sq = 0.f;
#pragma unroll
    for (int q = 0; q < 8; ++q) { float dlt = ys[q] - mean; sq += dlt * dlt; }
    sq = red8(sq);
    const float rstd = rsqrtf(sq * (1.f / 64.f) + 64e-5f);
    const int hA = lane >> 3;
    const float bon = p.BON[(size_t)tok * 8 + hA] + p.BON[((size_t)NT + tok) * 8 + hA];
    float vc[8], vp[8], vn[8], ga[8];
    const _Float16* p1 = p.P1 + (size_t)tok * LD1 + 1024 + c0;
    ld8(p1, true, vc); ld8(p1 - LD1, pv, vp); ld8(p1 + LD1, nv, vn);
    _Float16* p2 = p.P2 + (size_t)tok * LD2;
    ld8nt(p2 + c0, ga);
    h8 za;
#pragma unroll
    for (int q = 0; q < 8; ++q) {
      const int ch = c0 + q;
      float vsft = vc[q] + kmu[q >> 2][q & 3] * (0.5f * (vp[q] + vn[q]) - vc[q]);
      float gn = (ys[q] - mean) * rstd * kgw[q >> 2][q & 3] + kgb[q >> 2][q & 3];
      za[q] = (_Float16)((gn + bon * vsft) * siluf_(ga[q]));
    }
    *(h8*)(p2 + c0) = za;
    float bsg[8], cuc[8], cup[8], cun[8];
    ld8nt(p2 + 512 + c0, bsg); ld8(p2 + 1024 + c0, true, cuc);
    int dp; bool pvb, nvb;
    if (is_lat && lane >= 32) { dp = 64; pvb = t >= 64; nvb = t < 4096 - 64; } else { dp = 1; pvb = pv; nvb = nv; }
    ld8(p2 - (size_t)dp * LD2 + 1024 + c0, pvb, cup);
    ld8(p2 + (size_t)dp * LD2 + 1024 + c0, nvb, cun);
    h8 zb;
#pragma unroll
    for (int q = 0; q < 8; ++q) {
      const int ch = c0 + q;
      float conv = kw0[q >> 2][q & 3] * cup[q] + kw1[q >> 2][q & 3] * cuc[q] + kw2[q >> 2][q & 3] * cun[q];
      zb[q] = (_Float16)(bsg[q] * conv);
    }
    *(h8*)(p2 + 512 + c0) = zb;
  }
}

__device__ __forceinline__ void phase6(const Params& p) {
  int tid = threadIdx.x; asm volatile("" : "+v"(tid));
  const int lane = tid & 63, w = tid >> 6;
  for (int tok0 = blockIdx.x * 8 + w; tok0 < NT / 2; tok0 += gridDim.x * 8) {
    h8 v[2][2]; float ss[2];
#pragma unroll
    for (int u = 0; u < 2; ++u) {
      const _Float16* zr = p.HY + (size_t)(tok0 + u * (NT / 2)) * DM;
      v[u][0] = __builtin_nontemporal_load((const h8*)(zr + lane * 8)); v[u][1] = __builtin_nontemporal_load((const h8*)(zr + 512 + lane * 8));
    }
#pragma unroll
    for (int u = 0; u < 2; ++u) {
      float t = 0.f;
#pragma unroll
      for (int i = 0; i < 2; ++i)
#pragma unroll
        for (int q = 0; q < 8; ++q) { const float x = (float)v[u][i][q]; t += x * x; }
      ss[u] = red64(t);
    }
#pragma unroll
    for (int u = 0; u < 2; ++u) {
      float* orow = p.out + (size_t)(tok0 + u * (NT / 2)) * DM;
      const float rstd = rsqrtf(ss[u] * (1.f / 1024.f) + 1e-6f);
#pragma unroll
      for (int i = 0; i < 2; ++i) {
        const int col = i * 512 + lane * 8;
        const f4 g0 = *(const f4*)(p.final_g + col), g1 = *(const f4*)(p.final_g + col + 4);
        f4 o0, o1;
#pragma unroll
        for (int q = 0; q < 4; ++q) { o0[q] = (float)v[u][i][q] * rstd * g0[q]; o1[q] = (float)v[u][i][4 + q] * rstd * g1[q]; }
        __builtin_nontemporal_store(o0, (f4*)(orow + col)); __builtin_nontemporal_store(o1, (f4*)(orow + col + 4));
      }
    }
  }
}

__device__ __forceinline__ void grid_barrier(unsigned* bar, unsigned target) {
  asm volatile("s_waitcnt vmcnt(0)" ::: "memory");
  __syncthreads();
  if (threadIdx.x == 0) {
    __builtin_amdgcn_fence(__ATOMIC_RELEASE, "agent");
    asm volatile("s_waitcnt vmcnt(0)" ::: "memory");
    __hip_atomic_fetch_add(bar, 1u, __ATOMIC_RELAXED, __HIP_MEMORY_SCOPE_AGENT);
    while (__hip_atomic_load(bar, __ATOMIC_RELAXED, __HIP_MEMORY_SCOPE_AGENT) < target) __builtin_amdgcn_s_sleep(1);
    __builtin_amdgcn_fence(__ATOMIC_ACQUIRE, "agent");
    asm volatile("s_waitcnt vmcnt(0)" ::: "memory");
  }
  __syncthreads();
}

__global__ void __launch_bounds__(NTHREADS, 2) mega_kernel(Params p) {
  __shared__ __attribute__((aligned(16))) unsigned char smem[SMEM_BYTES];
  cg::grid_group grid = cg::this_grid();
#ifndef PH_MASK
#define PH_MASK 0x7F
#endif
  unsigned nbar = 0;
  if (PH_MASK & 1) phase0(p, smem);
  if (blockIdx.x < 48) {
    asm volatile("s_waitcnt vmcnt(0)" ::: "memory");
    __syncthreads();
    if (threadIdx.x == 0) { __builtin_amdgcn_fence(__ATOMIC_RELEASE, "agent"); asm volatile("s_waitcnt vmcnt(0)" ::: "memory"); __hip_atomic_fetch_add(p.bar + 32, 1u, __ATOMIC_RELAXED, __HIP_MEMORY_SCOPE_AGENT); }
  }
  if (p.bar == nullptr) grid.sync();
  if (PH_MASK & 2) {
    phase_weights(p, smem);
    if (threadIdx.x == 0) {
      const unsigned need = gridDim.x < 48u ? gridDim.x : 48u;
      while (__hip_atomic_load(p.bar + 32, __ATOMIC_RELAXED, __HIP_MEMORY_SCOPE_AGENT) < need) __builtin_amdgcn_s_sleep(1);
      __builtin_amdgcn_fence(__ATOMIC_ACQUIRE, "agent");
      asm volatile("s_waitcnt vmcnt(0)" ::: "memory");
    }
    __syncthreads();
    phase1(p);
  }
  grid_barrier(p.bar, ++nbar * gridDim.x);
#ifdef DUP_SMALL
  phase0(p, smem);
  grid_barrier(p.bar, ++nbar * gridDim.x);
  phase1(p);
  grid_barrier(p.bar, ++nbar * gridDim.x);
#endif
  if (PH_MASK & 4) { pg8::Gemm g_{(const pg8::bf16_t*)p.HY, (const pg8::bf16_t*)p.WCAT, NT, NCAT, DM, DM}; pg8::StaticOrder S_; S_.init(NT, NCAT, gridDim.x, blockIdx.x); EpiProj E_{p.P1, p.P2}; pg8::gemm_phase((PG8_LAS unsigned char*)smem, g_, S_, E_); }
  grid_barrier(p.bar, ++nbar * gridDim.x);
#ifdef DUP_G1
  { pg8::Gemm g_{(const pg8::bf16_t*)p.HY, (const pg8::bf16_t*)p.WCAT, NT, NCAT, DM, DM}; pg8::StaticOrder S_; S_.init(NT, NCAT, gridDim.x, blockIdx.x); EpiProj E_{p.P1, p.P2}; pg8::gemm_phase((PG8_LAS unsigned char*)smem, g_, S_, E_); }
  grid_barrier(p.bar, ++nbar * gridDim.x);
#endif
  if (PH_MASK & 8) scan_phase(p, smem);
  grid_barrier(p.bar, ++nbar * gridDim.x);
#ifdef DUP_SCAN
  scan_phase(p, smem);
  grid_barrier(p.bar, ++nbar * gridDim.x);
#endif
  if (PH_MASK & 16) phase4(p);
  grid_barrier(p.bar, ++nbar * gridDim.x);
  if (PH_MASK & 32) { pg8::Gemm g_{(const pg8::bf16_t*)p.P2, (const pg8::bf16_t*)p.WOUT, NT, DM, DM, LD2}; pg8::StaticOrder S_; S_.init(NT, DM, gridDim.x, blockIdx.x); EpiOut E_{p.x_prompt, p.x_sample, p.MOD, p.HY}; pg8::gemm_phase((PG8_LAS unsigned char*)smem, g_, S_, E_); }
  grid_barrier(p.bar, ++nbar * gridDim.x);
#ifdef DUP_SMALL
  { pg8::Gemm g_{(const pg8::bf16_t*)p.P2, (const pg8::bf16_t*)p.WOUT, NT, DM, DM, LD2}; pg8::StaticOrder S_; S_.init(NT, DM, gridDim.x, blockIdx.x); EpiOut E_{p.x_prompt, p.x_sample, p.MOD, p.HY}; pg8::gemm_phase((PG8_LAS unsigned char*)smem, g_, S_, E_); }
  grid_barrier(p.bar, ++nbar * gridDim.x);
#endif
  if (PH_MASK & 64) phase6(p);
}

extern "C" void kernel_launch(void* const* d_in, const int* in_sizes, int n_in, void* d_out, int out_size, void* d_ws,
                              size_t ws_size, hipStream_t stream) {
  static int grid_blocks = 0;
  if (!grid_blocks) {
    int dev = 0, cus = 0, per_cu = 0;
    hipGetDevice(&dev);
    hipDeviceGetAttribute(&cus, hipDeviceAttributeMultiprocessorCount, dev);
    hipOccupancyMaxActiveBlocksPerMultiprocessor(&per_cu, mega_kernel, NTHREADS, 0);
    if (per_cu > 1) per_cu = 1;
    if (per_cu < 1) per_cu = 1;
    grid_blocks = cus * per_cu;
  }
  Params p{};
  const float* const* in = (const float* const*)d_in;
  p.x_prompt = in[0]; p.x_sample = in[1]; p.c = in[2]; p.state = in[3]; p.c_ctx = in[4]; p.w_ada = in[5]; p.b_ada = in[6];
  p.norm_g = in[7]; p.w_in = in[8]; p.shift_mu = in[9]; p.decay_w0 = in[10]; p.decay_down = in[11]; p.decay_up = in[12];
  p.iclr_bias = in[13]; p.iclr_down = in[14]; p.iclr_up = in[15]; p.kk_scale = in[16]; p.ka_scale = in[17];
  p.bonus_rk = in[18]; p.gn_w = in[19]; p.gn_b = in[20]; p.conv_w = in[21]; p.w_out = in[22]; p.final_g = in[23];
  p.out = (float*)d_out;
  unsigned char* ws = (unsigned char*)d_ws;
  size_t off = 0;
  p.MOD = (float*)(ws + off); p.bar = (unsigned*)(ws + off + 122880); off += 131072;
  p.WCAT = (_Float16*)(ws + off); off += (size_t)NCAT * 1024 * 2;
  p.WOUT = (_Float16*)(ws + off); off += (size_t)1024 * 1024 * 2;
  p.UPT = (_Float16*)(ws + off); off += (size_t)4 * 512 * 64 * 2;
  p.BON = (float*)(ws + off); off += (size_t)2 * NT * 8 * 4;
  p.HY = (_Float16*)(ws + off); off += (size_t)NT * 1024 * 2;
  p.P1 = (_Float16*)(ws + off); off += (size_t)NT * LD1 * 2;
  p.P2 = (_Float16*)(ws + off); off += (size_t)NT * LD2 * 2;
  if (off > ws_size) { fprintf(stderr, "workspace too small: need %zu have %zu\n", off, ws_size); return; }
  hipMemsetAsync(p.bar, 0, 256, stream);
  void* args[] = {&p};
  hipError_t err = hipLaunchCooperativeKernel((void*)mega_kernel, dim3(grid_blocks), dim3(NTHREADS), args, 0, stream);
  if (err != hipSuccess) fprintf(stderr, "cooperative launch failed: %s (grid %d)\n", hipGetErrorString(err), grid_blocks);
}
```
